# Optimizing an MI355X kernel written in HIP

```python
import math
import jax, jax.numpy as jnp
from jax import lax
import numpy as np

D_MODEL = 1024
BATCH = 2
SEQ = 8192
DEPTH = 2

SSM_WIDTH = 512
SSM_GROUP = 16
SSM_GROUPS = SSM_WIDTH // SSM_GROUP
SSM_STATE = 64
LOG_DT_MIN = math.log(1e-3)
LOG_DT_MAX = math.log(1e-1)
ATTN_HEADS = 8
HEAD_DIM = 64
ATTN_WIDTH = ATTN_HEADS * HEAD_DIM
Q_BLOCK = 128
D_FF = 2816
FFN_RES = 0.5
N_SUB = 3
RMS_EPS = 1e-6
IN_WIDTH = SSM_WIDTH + 3 * ATTN_WIDTH + ATTN_HEADS + 2 * D_MODEL

kernel_name = "hybrid_s5_fox_macaron_adaln"


def rms_norm(x, g):
    xf = x.astype(jnp.float32)
    xf = xf * lax.rsqrt(jnp.mean(xf * xf, axis=-1, keepdims=True) + RMS_EPS)
    return (xf * g.astype(jnp.float32)).astype(x.dtype)


def swiglu(h, w_in, w_out):
    gate, up = jnp.split(h @ w_in, 2, axis=-1)
    return (jax.nn.silu(gate) * up) @ w_out


def s5_ssm(u, a_re, a_im, log_dt, b_re, b_im, c_re, c_im, d_skip):
    f32 = jnp.float32
    bsz, L, _ = u.shape
    uf = u.astype(f32).reshape(bsz, L, SSM_GROUPS, SSM_GROUP)
    lam = lax.complex(jnp.minimum(a_re.astype(f32), -1e-4), a_im.astype(f32))
    dt = jnp.exp(log_dt.astype(f32))[:, None]
    lam_bar = jnp.exp(lam * dt)
    b = lax.complex(b_re.astype(f32), b_im.astype(f32))
    b_bar = ((lam_bar - 1.0) / lam)[..., None] * b
    bu = jnp.einsum('blgn,gpn->blgp', uf.astype(jnp.complex64), b_bar)
    a_all = jnp.broadcast_to(lam_bar, bu.shape)

    def combine(e1, e2):
        a1, s1 = e1
        a2, s2 = e2
        return a2 * a1, a2 * s1 + s2

    _, states = lax.associative_scan(combine, (a_all, bu), axis=1)
    c = lax.complex(c_re.astype(f32), c_im.astype(f32))
    y = jnp.real(jnp.einsum('gnp,blgp->blgn', c, states))
    y = y + d_skip.astype(f32).reshape(SSM_GROUPS, SSM_GROUP) * uf
    return y.reshape(bsz, L, SSM_WIDTH).astype(u.dtype)


def forgetting_attention(q, k, v, f_logit):
    f32 = jnp.float32
    bsz, L, H, Dh = q.shape
    nb = L // Q_BLOCK
    log_f = jax.nn.log_sigmoid(f_logit.astype(f32))
    cum = jnp.cumsum(log_f, axis=1).transpose(0, 2, 1)
    kt = k.transpose(0, 2, 1, 3)
    vt = v.transpose(0, 2, 1, 3)
    qb = q.transpose(0, 2, 1, 3).reshape(bsz, H, nb, Q_BLOCK, Dh).transpose(2, 0, 1, 3, 4)
    cqb = cum.reshape(bsz, H, nb, Q_BLOCK).transpose(2, 0, 1, 3)
    starts = jnp.arange(nb, dtype=jnp.int32) * Q_BLOCK
    k_pos = jnp.arange(L, dtype=jnp.int32)
    scale = Dh ** -0.5

    def one_block(args):
        q_blk, cq_blk, start = args
        s = jnp.einsum('bhqd,bhkd->bhqk', q_blk, kt).astype(f32) * scale
        s = s + (cq_blk[..., None] - cum[:, :, None, :])
        q_pos = start + jnp.arange(Q_BLOCK, dtype=jnp.int32)
        s = jnp.where(k_pos[None, :] <= q_pos[:, None], s, -jnp.inf)
        p = jax.nn.softmax(s, axis=-1).astype(vt.dtype)
        return jnp.einsum('bhqk,bhkd->bhqd', p, vt)

    out = lax.map(one_block, (qb, cqb, starts))
    return out.transpose(1, 0, 3, 2, 4).reshape(bsz, L, H * Dh)


def token_mixer(h, w_in, forget_b, a_re, a_im, log_dt, b_re, b_im, c_re, c_im,
                d_skip, glu_w, attn_w_out, w_out):
    bsz, L, _ = h.shape
    proj = h @ w_in
    cuts = np.cumsum([SSM_WIDTH, ATTN_WIDTH, ATTN_WIDTH, ATTN_WIDTH, ATTN_HEADS, D_MODEL]).tolist()
    u, q, k, v, f, g_a, g_b = jnp.split(proj, cuts, axis=-1)
    y_ssm = s5_ssm(u, a_re, a_im, log_dt, b_re, b_im, c_re, c_im, d_skip)
    z_val, z_gate = jnp.split(jax.nn.gelu(y_ssm) @ glu_w, 2, axis=-1)
    y_a = z_val * jax.nn.sigmoid(z_gate)
    shp = (bsz, L, ATTN_HEADS, HEAD_DIM)
    attn = forgetting_attention(q.reshape(shp), k.reshape(shp), v.reshape(shp), f + forget_b)
    y_b = attn @ attn_w_out
    merged = jax.nn.sigmoid(g_a) * y_a + jax.nn.sigmoid(g_b) * y_b
    return merged @ w_out


def setup_inputs(seed: int = 0) -> dict:
    key = jax.random.key(seed)
    ks = jax.random.split(key, 24)
    f32 = jnp.float32
    nrm = lambda k, shape, s: jax.random.normal(k, shape, f32) * s
    D, G, P, N = D_MODEL, SSM_GROUPS, SSM_STATE, SSM_GROUP
    a_im_init = jnp.pi * jnp.arange(P, dtype=f32)
    return {
        "x": nrm(ks[0], (BATCH, SEQ, D), 1.0),
        "c": nrm(ks[1], (BATCH, D), 1.0),
        "mod_w": nrm(ks[2], (DEPTH, D, N_SUB * 3 * D), 0.5 * D ** -0.5),
        "mod_b": nrm(ks[3], (DEPTH, N_SUB * 3 * D), 0.01),
        "norm_pre": 1.0 + nrm(ks[4], (DEPTH, N_SUB, D), 0.02),
        "norm_post": 1.0 + nrm(ks[5], (DEPTH, N_SUB, D), 0.02),
        "ffn_w_in": nrm(ks[6], (DEPTH, 2, D, 2 * D_FF), D ** -0.5),
        "ffn_w_out": nrm(ks[7], (DEPTH, 2, D_FF, D), D_FF ** -0.5),
        "mix_w_in": nrm(ks[8], (DEPTH, D, IN_WIDTH), D ** -0.5),
        "forget_b": 3.0 + nrm(ks[9], (DEPTH, ATTN_HEADS), 0.5),
        "ssm_a_re": -0.5 + nrm(ks[10], (DEPTH, G, P), 0.01),
        "ssm_a_im": a_im_init + nrm(ks[11], (DEPTH, G, P), 0.01),
        "ssm_log_dt": jax.random.uniform(ks[12], (DEPTH, G), f32, LOG_DT_MIN, LOG_DT_MAX),
        "ssm_b_re": nrm(ks[13], (DEPTH, G, P, N), (2 * N) ** -0.5),
        "ssm_b_im": nrm(ks[14], (DEPTH, G, P, N), (2 * N) ** -0.5),
        "ssm_c_re": nrm(ks[15], (DEPTH, G, N, P), (2 * P) ** -0.5),
        "ssm_c_im": nrm(ks[16], (DEPTH, G, N, P), (2 * P) ** -0.5),
        "ssm_d": nrm(ks[17], (DEPTH, SSM_WIDTH), 1.0),
        "glu_w": nrm(ks[18], (DEPTH, SSM_WIDTH, 2 * D), SSM_WIDTH ** -0.5),
        "attn_w_out": nrm(ks[19], (DEPTH, ATTN_WIDTH, D), ATTN_WIDTH ** -0.5),
        "mix_w_out": nrm(ks[20], (DEPTH, D, D), D ** -0.5),
    }


def reference(x, c, mod_w, mod_b, norm_pre, norm_post, ffn_w_in, ffn_w_out,
              mix_w_in, forget_b, ssm_a_re, ssm_a_im, ssm_log_dt, ssm_b_re,
              ssm_b_im, ssm_c_re, ssm_c_im, ssm_d, glu_w, attn_w_out, mix_w_out):
    bsz = x.shape[0]
    for l in range(DEPTH):
        mod = (jax.nn.silu(c) @ mod_w[l] + mod_b[l]).reshape(bsz, N_SUB, 3, D_MODEL)
        mod = mod[:, :, :, None, :]

        def pre(x_in, i):
            return rms_norm(x_in, norm_pre[l, i]) * (1.0 + mod[:, i, 1]) + mod[:, i, 0]

        def post_add(x_in, y, i, res_w):
            return x_in + res_w * mod[:, i, 2] * rms_norm(y, norm_post[l, i])

        x = post_add(x, swiglu(pre(x, 0), ffn_w_in[l, 0], ffn_w_out[l, 0]), 0, FFN_RES)
        y = token_mixer(pre(x, 1), mix_w_in[l], forget_b[l], ssm_a_re[l], ssm_a_im[l],
                        ssm_log_dt[l], ssm_b_re[l], ssm_b_im[l], ssm_c_re[l], ssm_c_im[l],
                        ssm_d[l], glu_w[l], attn_w_out[l], mix_w_out[l])
        x = post_add(x, y, 1, 1.0)
        x = post_add(x, swiglu(pre(x, 2), ffn_w_in[l, 1], ffn_w_out[l, 1]), 2, FFN_RES)
    return x
```

```cpp
#include <hip/hip_runtime.h>
#include <cstdio>
#include <cstdint>
#include <cmath>
namespace nv {
constexpr int D = 1024, NB = 2, L = 8192, M = NB * L, DEPTH = 2, FF = 2816, INW = 4104, H = 8, HD = 64, G = 32, P = 64, NG = 16;
constexpr int MODW = 9216;

__device__ __forceinline__ float sigmoidf_(float v) { return 1.f / (1.f + expf(-v)); }
__device__ __forceinline__ float siluf_(float v) { return v / (1.f + expf(-v)); }
__device__ __forceinline__ float geluf_(float v) { return 0.5f * v * (1.f + tanhf(0.7978845608028654f * (v + 0.044715f * v * v * v))); }
__device__ __forceinline__ float logsigf_(float f) { return fminf(f, 0.f) - log1pf(expf(-fabsf(f))); }

__global__ void k_mod(const float* __restrict__ c, const float* __restrict__ mod_w, const float* __restrict__ mod_b, float* __restrict__ mod) {
    const int j = blockIdx.x * 256 + threadIdx.x, l = blockIdx.y;
    const float* w = mod_w + (size_t)l * D * MODW;
    float a0 = 0.f, a1 = 0.f;
    for (int k = 0; k < D; ++k) { const float wv = w[(size_t)k * MODW + j]; a0 += siluf_(c[k]) * wv; a1 += siluf_(c[D + k]) * wv; }
    mod[(l * 2 + 0) * MODW + j] = a0 + mod_b[l * MODW + j];
    mod[(l * 2 + 1) * MODW + j] = a1 + mod_b[l * MODW + j];
}
__device__ __forceinline__ float block_sum_256(float v, float* sh) {
    for (int o = 32; o > 0; o >>= 1) v += __shfl_xor(v, o);
    if ((threadIdx.x & 63) == 0) sh[threadIdx.x >> 6] = v;
    __syncthreads();
    const float r = (sh[0] + sh[1]) + (sh[2] + sh[3]);
    __syncthreads();
    return r;
}
__global__ void k_prenorm(const float* __restrict__ x, const float* __restrict__ g, const float* __restrict__ modl, int sub, float* __restrict__ h) {
    __shared__ float sh[4];
    const int row = blockIdx.x, b = row / L;
    const float* xr = x + (size_t)row * D;
    float v0 = xr[threadIdx.x], v1 = xr[threadIdx.x + 256], v2 = xr[threadIdx.x + 512], v3 = xr[threadIdx.x + 768];
    const float s = block_sum_256(v0 * v0 + v1 * v1 + v2 * v2 + v3 * v3, sh);
    const float r = rsqrtf(s / D + 1e-6f);
    const float* shift = modl + b * MODW + sub * 3 * D; const float* scale = shift + D;
    float* hr = h + (size_t)row * D;
    int d = threadIdx.x;
    hr[d] = v0 * r * g[d] * (1.f + scale[d]) + shift[d]; d += 256;
    hr[d] = v1 * r * g[d] * (1.f + scale[d]) + shift[d]; d += 256;
    hr[d] = v2 * r * g[d] * (1.f + scale[d]) + shift[d]; d += 256;
    hr[d] = v3 * r * g[d] * (1.f + scale[d]) + shift[d];
}
__global__ void k_postadd(const float* __restrict__ xi, float* __restrict__ xo, const float* __restrict__ y, const float* __restrict__ g, const float* __restrict__ modl, int sub, float resw, int row0) {
    __shared__ float sh[4];
    const int row = row0 + blockIdx.x, b = row / L;
    const float* yr = y + (size_t)blockIdx.x * D;
    float v0 = yr[threadIdx.x], v1 = yr[threadIdx.x + 256], v2 = yr[threadIdx.x + 512], v3 = yr[threadIdx.x + 768];
    const float s = block_sum_256(v0 * v0 + v1 * v1 + v2 * v2 + v3 * v3, sh);
    const float r = rsqrtf(s / D + 1e-6f);
    const float* gate = modl + b * MODW + sub * 3 * D + 2 * D;
    const float* xr = xi + (size_t)row * D; float* xw = xo + (size_t)row * D;
    int d = threadIdx.x;
    xw[d] = xr[d] + resw * gate[d] * (v0 * r * g[d]); d += 256;
    xw[d] = xr[d] + resw * gate[d] * (v1 * r * g[d]); d += 256;
    xw[d] = xr[d] + resw * gate[d] * (v2 * r * g[d]); d += 256;
    xw[d] = xr[d] + resw * gate[d] * (v3 * r * g[d]);
}
template <int MODE>
__global__ __launch_bounds__(256) void k_gemm(const float* __restrict__ A, int lda, const float* __restrict__ Bm, int ldb, float* __restrict__ C, int ldc, int N, int K) {
    __shared__ float As[16][68]; __shared__ float Bs[16][68]; __shared__ float Bs2[MODE ? 16 : 1][68];
    const int tx = threadIdx.x & 15, ty = threadIdx.x >> 4;
    const int m0 = blockIdx.y * 64, n0 = blockIdx.x * 64;
    float acc[4][4], acc2[4][4];
#pragma unroll
    for (int i = 0; i < 4; ++i)
#pragma unroll
        for (int j = 0; j < 4; ++j) { acc[i][j] = 0.f; acc2[i][j] = 0.f; }
    for (int k0 = 0; k0 < K; k0 += 16) {
        { const int r = threadIdx.x >> 2, kk = (threadIdx.x & 3) * 4; const float4 v = *(const float4*)(A + (size_t)(m0 + r) * lda + k0 + kk);
          As[kk][r] = v.x; As[kk + 1][r] = v.y; As[kk + 2][r] = v.z; As[kk + 3][r] = v.w; }
        { const int kk = threadIdx.x >> 4, n = (threadIdx.x & 15) * 4; const float* bp = Bm + (size_t)(k0 + kk) * ldb + n0 + n;
#pragma unroll
          for (int i = 0; i < 4; ++i) { Bs[kk][n + i] = (n0 + n + i < N) ? bp[i] : 0.f; if (MODE) Bs2[kk][n + i] = (n0 + n + i < N) ? bp[N + i] : 0.f; } }
        __syncthreads();
#pragma unroll
        for (int kk = 0; kk < 16; ++kk) {
            const float4 a = *(const float4*)&As[kk][ty * 4]; const float4 b = *(const float4*)&Bs[kk][tx * 4];
            const float av[4] = {a.x, a.y, a.z, a.w}; const float bv[4] = {b.x, b.y, b.z, b.w};
#pragma unroll
            for (int i = 0; i < 4; ++i)
#pragma unroll
                for (int j = 0; j < 4; ++j) acc[i][j] += av[i] * bv[j];
            if (MODE) { const float4 b2 = *(const float4*)&Bs2[kk][tx * 4]; const float bw[4] = {b2.x, b2.y, b2.z, b2.w};
#pragma unroll
                for (int i = 0; i < 4; ++i)
#pragma unroll
                    for (int j = 0; j < 4; ++j) acc2[i][j] += av[i] * bw[j]; }
        }
        __syncthreads();
    }
#pragma unroll
    for (int i = 0; i < 4; ++i)
#pragma unroll
        for (int j = 0; j < 4; ++j) { const int n = n0 + tx * 4 + j; if (n < N) { float v = acc[i][j];
            if (MODE == 1) v = siluf_(v) * acc2[i][j]; if (MODE == 2) v = v * sigmoidf_(acc2[i][j]);
            C[(size_t)(m0 + ty * 4 + i) * ldc + n] = v; } }
}
__global__ void k_cum(const float* __restrict__ proj, int ldp, const float* __restrict__ fb, float* __restrict__ cum) {
    __shared__ float sh[256];
    const int h = blockIdx.x, t0 = threadIdx.x * 32;
    float s = 0.f;
    for (int i = 0; i < 32; ++i) s += logsigf_(proj[(size_t)(t0 + i) * ldp + 2048 + h] + fb[h]);
    sh[threadIdx.x] = s; __syncthreads();
    float run = 0.f; for (int j = 0; j < (int)threadIdx.x; ++j) run += sh[j];
    for (int i = 0; i < 32; ++i) { run += logsigf_(proj[(size_t)(t0 + i) * ldp + 2048 + h] + fb[h]); cum[h * L + t0 + i] = run; }
}
__global__ __launch_bounds__(64) void k_attn(const float* __restrict__ proj, int ldp, const float* __restrict__ cum, float* __restrict__ out) {
    const int qb = gridDim.x - 1 - blockIdx.x, h = blockIdx.y;
    const int t = qb * 64 + threadIdx.x;
    const float* qp = proj + (size_t)t * ldp + 512 + h * 64;
    float q[64], o[64];
#pragma unroll
    for (int d = 0; d < 64; ++d) { q[d] = qp[d] * 0.125f; o[d] = 0.f; }
    float m = -INFINITY, l = 0.f; const float* cb = cum + h * L; const float cq = cb[t];
    const int kend = qb * 64 + 64;
    for (int s = 0; s < kend; ++s) {
        const float* kp = proj + (size_t)s * ldp + 1024 + h * 64; const float* vp = kp + 512;
        float sc = 0.f;
#pragma unroll
        for (int d = 0; d < 64; ++d) sc += q[d] * kp[d];
        sc += cq - cb[s];
        if (s <= t) {
            if (sc > m) { const float a = expf(m - sc); l *= a;
#pragma unroll
                for (int d = 0; d < 64; ++d) o[d] *= a;
                m = sc; }
            const float p = expf(sc - m); l += p;
#pragma unroll
            for (int d = 0; d < 64; ++d) o[d] += p * vp[d];
        }
    }
    const float il = 1.f / l;
#pragma unroll
    for (int d = 0; d < 64; ++d) out[(size_t)t * 512 + h * 64 + d] = o[d] * il;
}
__global__ __launch_bounds__(64) void k_ssm(const float* __restrict__ proj, int ldp, const float* __restrict__ a_re, const float* __restrict__ a_im, const float* __restrict__ log_dt,
                                          const float* __restrict__ b_re, const float* __restrict__ b_im, const float* __restrict__ c_re, const float* __restrict__ c_im, const float* __restrict__ dsk, float* __restrict__ y) {
    __shared__ float xs[2][64];
    const int g = blockIdx.x, p = threadIdx.x;
    const double ar = fmin((double)a_re[g * P + p], -1e-4), ai = (double)a_im[g * P + p], dt = exp((double)log_dt[g]);
    const double ea = exp(ar * dt), lr = ea * cos(ai * dt), li = ea * sin(ai * dt);
    const double nr = expm1(ar * dt) * cos(ai * dt) - 2.0 * sin(0.5 * ai * dt) * sin(0.5 * ai * dt), ni = li, den = ar * ar + ai * ai;
    const double fr = (nr * ar + ni * ai) / den, fi = (ni * ar - nr * ai) / den;
    float bbr[16], bbi[16];
#pragma unroll
    for (int n = 0; n < 16; ++n) { const double br = b_re[(g * P + p) * NG + n], bi = b_im[(g * P + p) * NG + n]; bbr[n] = (float)(fr * br - fi * bi); bbi[n] = (float)(fr * bi + fi * br); }
    const int n_o = p & 15, qd = p >> 4;
    float cr[16], ci[16];
#pragma unroll
    for (int j = 0; j < 16; ++j) { cr[j] = c_re[(g * NG + n_o) * P + qd * 16 + j]; ci[j] = c_im[(g * NG + n_o) * P + qd * 16 + j]; }
    const float lrf = (float)lr, lif = (float)li, dn = dsk[g * NG + n_o];
    float xr = 0.f, xi = 0.f;
    for (int t = 0; t < L; ++t) {
        const float* up = proj + (size_t)t * ldp + g * NG;
        float br = 0.f, bi = 0.f;
#pragma unroll
        for (int n = 0; n < 16; ++n) { const float uv = up[n]; br += bbr[n] * uv; bi += bbi[n] * uv; }
        const float nxr = lrf * xr - lif * xi + br, nxi = lrf * xi + lif * xr + bi; xr = nxr; xi = nxi;
        __syncthreads();
        xs[0][p] = xr; xs[1][p] = xi;
        __syncthreads();
        float s = 0.f;
#pragma unroll
        for (int j = 0; j < 16; ++j) s += cr[j] * xs[0][qd * 16 + j] - ci[j] * xs[1][qd * 16 + j];
        s += __shfl_xor(s, 16); s += __shfl_xor(s, 32);
        if (p < 16) y[(size_t)t * 512 + g * NG + n_o] = geluf_(s + dn * up[n_o]);
    }
}
__global__ void k_merge(float* __restrict__ ya, const float* __restrict__ yb, const float* __restrict__ pg) {
    const size_t i = (size_t)blockIdx.x * 256 + threadIdx.x; const size_t r = i / D, d = i % D;
    ya[i] = sigmoidf_(pg[r * 2048 + d]) * ya[i] + sigmoidf_(pg[r * 2048 + 1024 + d]) * yb[i];
}

struct In {
    const float *x, *c, *mod_w, *mod_b, *norm_pre, *norm_post, *ffn_w_in, *ffn_w_out, *mix_w_in, *forget_b, *a_re, *a_im, *log_dt, *b_re, *b_im, *c_re, *c_im, *ssm_d, *glu_w, *attn_w_out, *mix_w_out;
};
constexpr size_t SZ_X = (size_t)M * D * 4, OFF_X = 0, OFF_H = SZ_X, OFF_MOD = 2 * SZ_X, OFF_CUM = OFF_MOD + 262144, OFF_BIG = OFF_CUM + 262144;
constexpr size_t NAIVE_WS = OFF_BIG + (size_t)M * FF * 4;

static void forward(const In& in, float* out, unsigned char* ws, hipStream_t st, int stop_layer = DEPTH, int stop_stage = 99) {
    float* X = (float*)(ws + OFF_X); float* Hb = (float*)(ws + OFF_H); float* mod = (float*)(ws + OFF_MOD); float* cum = (float*)(ws + OFF_CUM);
    float* BIG = (float*)(ws + OFF_BIG);
    k_mod<<<dim3(MODW / 256, DEPTH), 256, 0, st>>>(in.c, in.mod_w, in.mod_b, mod);
    const float* xin = in.x;
    for (int l = 0; l < DEPTH; ++l) {
        const float* modl = mod + (size_t)l * 2 * MODW;
        for (int sub = 0; sub < 3; ++sub) {
            const float* gpre = in.norm_pre + (l * 3 + sub) * D; const float* gpost = in.norm_post + (l * 3 + sub) * D;
            const bool last = (l == DEPTH - 1 && sub == 2);
            float* xo = last ? out : X;
            k_prenorm<<<M, 256, 0, st>>>(xin, gpre, modl, sub, Hb);
            if (sub != 1) {
                const int f = sub == 0 ? 0 : 1;
                const float* win = in.ffn_w_in + (size_t)(l * 2 + f) * D * 2 * FF; const float* wout = in.ffn_w_out + (size_t)(l * 2 + f) * FF * D;
                k_gemm<1><<<dim3(FF / 64, M / 64), 256, 0, st>>>(Hb, D, win, 2 * FF, BIG, FF, FF, D);
                k_gemm<0><<<dim3(D / 64, M / 64), 256, 0, st>>>(BIG, FF, wout, D, Hb, D, D, FF);
                k_postadd<<<M, 256, 0, st>>>(xin, xo, Hb, gpost, modl, sub, 0.5f, 0);
            } else {
                const float* win = in.mix_w_in + (size_t)l * D * INW;
                for (int b = 0; b < NB; ++b) {
                    float* P1 = BIG;
                    float* YS = BIG + (size_t)L * 2056;
                    float* AT = YS + (size_t)L * 512;
                    float* YA = AT + (size_t)L * 512;
                    float* YB = YA + (size_t)L * D;
                    const float* hb = Hb + (size_t)b * L * D;
                    k_gemm<0><<<dim3((2056 + 63) / 64, L / 64), 256, 0, st>>>(hb, D, win, INW, P1, 2056, 2056, D);
                    k_cum<<<H, 256, 0, st>>>(P1, 2056, in.forget_b + l * H, cum);
                    k_attn<<<dim3(L / 64, H), 64, 0, st>>>(P1, 2056, cum, AT);
                    k_ssm<<<G, 64, 0, st>>>(P1, 2056, in.a_re + l * G * P, in.a_im + l * G * P, in.log_dt + l * G, in.b_re + (size_t)l * G * P * NG, in.b_im + (size_t)l * G * P * NG,
                                            in.c_re + (size_t)l * G * NG * P, in.c_im + (size_t)l * G * NG * P, in.ssm_d + l * 512, YS);
                    k_gemm<2><<<dim3(D / 64, L / 64), 256, 0, st>>>(YS, 512, in.glu_w + (size_t)l * 512 * 2048, 2048, YA, D, D, 512);
                    k_gemm<0><<<dim3(D / 64, L / 64), 256, 0, st>>>(AT, 512, in.attn_w_out + (size_t)l * 512 * D, D, YB, D, D, 512);
                    k_gemm<0><<<dim3(2048 / 64, L / 64), 256, 0, st>>>(hb, D, win + 2056, INW, P1, 2048, 2048, D);
                    k_merge<<<L * D / 256, 256, 0, st>>>(YA, YB, P1);
                    k_gemm<0><<<dim3(D / 64, L / 64), 256, 0, st>>>(YA, D, in.mix_w_out + (size_t)l * D * D, D, YB, D, D, D);
                    k_postadd<<<L, 256, 0, st>>>(xin, xo, YB, gpost, modl, sub, 1.0f, b * L);
                }
            }
            xin = xo;
        }
    }
}
}
extern "C" void kernel_launch(void* const* d_in, const int* in_sizes, int n_in, void* d_out, int out_size, void* d_ws, size_t ws_size, hipStream_t stream) {
    if (n_in != 21 || ws_size < nv::NAIVE_WS) { fprintf(stderr, "kernel_launch: bad n_in %d or ws %zu < %zu\n", n_in, ws_size, (size_t)nv::NAIVE_WS); return; }
    nv::In in;
    const float** pp = (const float**)&in;
    for (int i = 0; i < 21; ++i) pp[i] = (const float*)d_in[i];
    nv::forward(in, (float*)d_out, (unsigned char*)d_ws, stream);
}
```

```cpp
#include <hip/hip_runtime.h>
#include <hip/hip_cooperative_groups.h>
#include <cstdio>
#include <cstdint>
#include <cmath>
namespace pg8 {
#define PG8_LAS __attribute__((address_space(3)))
typedef unsigned short bf16_t;
typedef short bf16x8 __attribute__((ext_vector_type(8)));
typedef float f32x4 __attribute__((ext_vector_type(4)));
typedef unsigned u32x4 __attribute__((ext_vector_type(4)));
constexpr int BM = 256, BK = 64, HALF = 128, HTB = HALF * BK * 2  , STAGE_BYTES = 8 * HTB, NXCD = 8, WGM = 8;

__host__ __device__ __forceinline__ int lds_byte(int r, int c) { const int st = (r >> 4) * 2 + (c >> 5), rr = r & 15, cc = c & 31, ob = rr * 64 + cc * 2; return st * 1024 + (ob ^ (((ob >> 9) & 1) << 5)); }
__host__ __device__ __forceinline__ void stage_rc(int b, int& R, int& C) { const int st = b / 1024, sb = b % 1024, swz = sb ^ (((sb >> 9) & 1) << 5); R = (st >> 1) * 16 + swz / 64; C = (st & 1) * 32 + (swz % 64) / 2; }
__host__ __device__ __forceinline__ int perm32(int rho) { const int n = rho >> 4, i = rho & 15; return 8 * (i >> 2) + 4 * n + (i & 3); }

struct Unit { int pm, pn; };
struct Gemm { const bf16_t* A; const bf16_t* Bt; int M, N, K, lda, ldb; };

struct StaticOrder {
    int nM, nN, nwg, G, c;
    __host__ __device__ void init(int M, int N, int G_, int c_) { nM = M / BM; nN = N / BM; nwg = nM * nN; G = G_; c = c_; }
    __host__ __device__ bool next(int i, Unit& u) const {
        const long L = (long)i * G + c; if (L >= nwg) return false;
        int wgid = (int)L; { const int q = nwg / NXCD, r = nwg % NXCD, xcd = wgid % NXCD, off = wgid / NXCD; wgid = (xcd < r ? xcd * (q + 1) : r * (q + 1) + (xcd - r) * q) + off; }
        const int nig = WGM * nN, gid = wgid / nig, fm = gid * WGM, gsz = (nM - fm) < WGM ? (nM - fm) : WGM;
        u.pm = fm + ((wgid % nig) % gsz); u.pn = (wgid % nig) / gsz; return true;
    }
    __device__ __forceinline__ void a_ready(const Unit&) const {}
    __device__ __forceinline__ void done(const Unit&) const {}
};

__device__ __forceinline__ unsigned cvt_pk_bf16(float lo, float hi) { unsigned r; asm volatile("v_cvt_pk_bf16_f32 %0, %1, %2" : "=v"(r) : "v"(lo), "v"(hi)); return r; }
typedef float f32x2 __attribute__((ext_vector_type(2)));
__device__ __forceinline__ f32x2 gelu_pk(f32x2 v) {
    const f32x2 av = __builtin_elementwise_abs(v), d = av * 0.2316418882f + 1.0f;
    f32x2 t; t.x = __builtin_amdgcn_rcpf(d.x); t.y = __builtin_amdgcn_rcpf(d.y);
    f32x2 q = t * 0.5307027145f + (-0.7265760135f); q = q * t + 0.7107068705f; q = q * t + (-0.142248368f); q = q * t + 0.127414796f; q = q * t;
    const f32x2 s = (v * v) * (-0.72134752044f);
    f32x2 e; e.x = __builtin_amdgcn_exp2f(s.x); e.y = __builtin_amdgcn_exp2f(s.y);
    const f32x2 m = v * (q * e), r = v - m;
    f32x2 o; o.x = v.x < 0.f ? m.x : r.x; o.y = v.y < 0.f ? m.y : r.y; return o;
}
template <class Epi, class Sched, bool ALIGN_EPI = false, bool SP2 = false>
__device__ __forceinline__ void gemm_phase(PG8_LAS unsigned char* lds, const Gemm g, const Sched& S, const Epi& E) {
    int tid_ = threadIdx.x; asm volatile("" : "+v"(tid_));
    const int tid = tid_, wid = __builtin_amdgcn_readfirstlane(tid >> 6), lane = tid & 63, wr = wid >> 2, wc = wid & 3, fr = lane & 15, fq = lane >> 4;
    const int K = g.K, nt = K / BK;
    unsigned voffA[2], voffB[2];
#pragma unroll
    for (int i = 0; i < 2; ++i) { int R, C; stage_rc(tid * 16 + i * 8192, R, C); const int Rb = Epi::PERM ? ((R & ~31) + perm32(R & 31)) : R;
        voffA[i] = (unsigned)(R * g.lda + C) * 2u; voffB[i] = (unsigned)(Rb * g.ldb + C) * 2u; }
    const size_t kstep = (size_t)(BK * 2);
    const size_t hstepA = (size_t)HALF * g.lda * 2, hstepB = (size_t)HALF * g.ldb * 2;
    const size_t tstepA = 2 * hstepA, tstepB = 2 * hstepB;
    const unsigned ldsw = (unsigned)wid * 1024u;
    const int aoff = lds_byte(wr * 64 + fr, fq * 8), boff = lds_byte(wc * 32 + fr, fq * 8);
#define PG8_SA(b, h) (((b) * 2 + (h)) * HTB)
#define PG8_SB(b, h) ((4 + (b) * 2 + (h)) * HTB)
#define PG8_STAGE(bufoff, gbase, voff) do { _Pragma("unroll") for (int _i = 0; _i < 2; ++_i) \
        __builtin_amdgcn_global_load_lds((const unsigned*)((const char*)(gbase) + (voff)[_i]), (PG8_LAS unsigned*)(lds + (bufoff) + ldsw + _i * 8192), 16, 0, 0); } while (0)
#define PG8_LDA(dst, b, h) do { _Pragma("unroll") for (int m = 0; m < 4; ++m) _Pragma("unroll") for (int k = 0; k < 2; ++k) dst[m][k] = *(const PG8_LAS bf16x8*)(lds + PG8_SA(b, h) + aoff + m * 2048 + k * 1024); } while (0)
#define PG8_LDB(dst, b, h) do { _Pragma("unroll") for (int n = 0; n < 2; ++n) _Pragma("unroll") for (int k = 0; k < 2; ++k) dst[n][k] = *(const PG8_LAS bf16x8*)(lds + PG8_SB(b, h) + boff + n * 2048 + k * 1024); } while (0)
#define PG8_MMA(ai, bj, At, Bt) do { __builtin_amdgcn_s_setprio(1); _Pragma("unroll") for (int m = 0; m < 4; ++m) _Pragma("unroll") for (int n = 0; n < 2; ++n) _Pragma("unroll") for (int k = 0; k < 2; ++k) \
        acc[ai][bj][m][n] = __builtin_amdgcn_mfma_f32_16x16x32_bf16(Bt[n][k], At[m][k], acc[ai][bj][m][n], 0, 0, 0); __builtin_amdgcn_s_setprio(0); } while (0)
#define PG8_WAIT_V(n) asm volatile("s_waitcnt vmcnt(" #n ")" ::: "memory")
#define PG8_WAIT_L(n) asm volatile("s_waitcnt lgkmcnt(" #n ")" ::: "memory")
#define PG8_BAR __builtin_amdgcn_s_barrier()
#define PG8_SCHED __builtin_amdgcn_sched_barrier(0)
    Unit cur, nxt; int ui = 0;
    if (!S.next(0, cur)) return;
    f32x4 acc[2][2][4][2];
#pragma unroll
    for (int a = 0; a < 2; ++a)
#pragma unroll
        for (int b = 0; b < 2; ++b)
#pragma unroll
            for (int m = 0; m < 4; ++m)
#pragma unroll
                for (int n = 0; n < 2; ++n) acc[a][b][m][n] = (f32x4){0.f, 0.f, 0.f, 0.f};
    bf16x8 At[4][2], B0[2][2], B1[2][2];
    const char* cA = (const char*)g.A + (size_t)cur.pm * tstepA; const char* cB = (const char*)g.Bt + (size_t)cur.pn * tstepB;
    S.a_ready(cur);
    if constexpr (SP2) {
        PG8_STAGE(PG8_SB(0, 0), cB, voffB); PG8_STAGE(PG8_SB(0, 1), cB + hstepB, voffB); PG8_STAGE(PG8_SA(0, 0), cA, voffA); PG8_STAGE(PG8_SA(0, 1), cA + hstepA, voffA);
        if (wr == 1) PG8_BAR;
        PG8_WAIT_V(2); PG8_BAR;
        PG8_STAGE(PG8_SB(1, 0), cB + kstep, voffB); PG8_STAGE(PG8_SA(1, 0), cA + kstep, voffA); PG8_STAGE(PG8_SB(1, 1), cB + hstepB + kstep, voffB);
        PG8_WAIT_V(6); PG8_BAR;
    } else {
        PG8_STAGE(PG8_SB(0, 0), cB, voffB); PG8_STAGE(PG8_SA(0, 0), cA, voffA); PG8_STAGE(PG8_SB(0, 1), cB + hstepB, voffB); PG8_STAGE(PG8_SA(0, 1), cA + hstepA, voffA);
        if (wr == 1) PG8_BAR;
        PG8_WAIT_V(4); PG8_BAR;
        PG8_STAGE(PG8_SB(1, 0), cB + kstep, voffB); PG8_STAGE(PG8_SA(1, 0), cA + kstep, voffA); PG8_STAGE(PG8_SB(1, 1), cB + hstepB + kstep, voffB);
        PG8_WAIT_V(6); PG8_BAR;
    }
    for (;;) {
        const bool has_next = S.next(ui + 1, nxt);
        const char* nA = has_next ? (const char*)g.A + (size_t)nxt.pm * tstepA : cA; const char* nB = has_next ? (const char*)g.Bt + (size_t)nxt.pn * tstepB : cB;
        for (int t = 0; t < nt; t += 2) {
            const bool last = (t == nt - 2);
            const char* a1 = cA + (size_t)(t + 1) * kstep;
            const char* a2 = last ? nA : cA + (size_t)(t + 2) * kstep; const char* b2 = last ? nB : cB + (size_t)(t + 2) * kstep;
            const char* a3 = a2 + kstep; const char* b3 = b2 + kstep;
            if (last && has_next) S.a_ready(nxt);
            if constexpr (SP2) {
            PG8_LDB(B0, 0, 0); PG8_LDB(B1, 0, 1); PG8_SCHED; PG8_LDA(At, 0, 0); PG8_STAGE(PG8_SA(1, 1), a1 + hstepA, voffA);
            PG8_WAIT_V(8); PG8_WAIT_L(0); PG8_BAR; PG8_MMA(0, 0, At, B0); PG8_MMA(0, 1, At, B1); PG8_BAR; PG8_SCHED;
            PG8_LDA(At, 0, 1); PG8_STAGE(PG8_SB(0, 0), b2, voffB); PG8_STAGE(PG8_SB(0, 1), b2 + hstepB, voffB); PG8_STAGE(PG8_SA(0, 0), a2, voffA);
            PG8_WAIT_V(8); PG8_WAIT_L(0); PG8_BAR; PG8_MMA(1, 0, At, B0); PG8_MMA(1, 1, At, B1); PG8_BAR; PG8_SCHED;
            PG8_LDB(B0, 1, 0); PG8_LDB(B1, 1, 1); PG8_SCHED; PG8_LDA(At, 1, 0); PG8_STAGE(PG8_SA(0, 1), a2 + hstepA, voffA);
            PG8_WAIT_V(8); PG8_WAIT_L(0); PG8_BAR; PG8_MMA(0, 0, At, B0); PG8_MMA(0, 1, At, B1); PG8_BAR; PG8_SCHED;
            PG8_LDA(At, 1, 1); PG8_STAGE(PG8_SB(1, 0), b3, voffB); PG8_STAGE(PG8_SB(1, 1), b3 + hstepB, voffB); PG8_STAGE(PG8_SA(1, 0), a3, voffA);
            PG8_WAIT_V(8); PG8_WAIT_L(0); PG8_BAR; PG8_MMA(1, 0, At, B0); PG8_MMA(1, 1, At, B1); PG8_BAR; PG8_SCHED;
            } else {
            PG8_LDB(B0, 0, 0); PG8_SCHED; PG8_LDA(At, 0, 0); PG8_STAGE(PG8_SA(1, 1), a1 + hstepA, voffA);
            PG8_WAIT_L(8); PG8_BAR; PG8_WAIT_L(0); PG8_MMA(0, 0, At, B0); PG8_BAR; PG8_SCHED;
            PG8_LDB(B1, 0, 1); PG8_STAGE(PG8_SB(0, 0), b2, voffB);
            PG8_BAR; PG8_WAIT_L(0); PG8_MMA(0, 1, At, B1); PG8_BAR;
            PG8_LDA(At, 0, 1); PG8_STAGE(PG8_SA(0, 0), a2, voffA);
            PG8_BAR; PG8_WAIT_L(0); PG8_MMA(1, 0, At, B0); PG8_BAR; PG8_SCHED;
            PG8_STAGE(PG8_SB(0, 1), b2 + hstepB, voffB);
            PG8_WAIT_V(6); PG8_BAR; PG8_MMA(1, 1, At, B1); PG8_BAR;
            PG8_LDB(B0, 1, 0); PG8_SCHED; PG8_LDA(At, 1, 0); PG8_STAGE(PG8_SA(0, 1), a2 + hstepA, voffA);
            PG8_WAIT_L(8); PG8_BAR; PG8_WAIT_L(0); PG8_MMA(0, 0, At, B0); PG8_BAR; PG8_SCHED;
            PG8_LDB(B1, 1, 1); PG8_STAGE(PG8_SB(1, 0), b3, voffB);
            PG8_BAR; PG8_WAIT_L(0); PG8_MMA(0, 1, At, B1); PG8_BAR;
            PG8_LDA(At, 1, 1); PG8_STAGE(PG8_SA(1, 0), a3, voffA);
            PG8_BAR; PG8_WAIT_L(0); PG8_MMA(1, 0, At, B0); PG8_BAR; PG8_SCHED;
            PG8_STAGE(PG8_SB(1, 1), b3 + hstepB, voffB);
            PG8_WAIT_V(6); PG8_BAR; PG8_MMA(1, 1, At, B1); PG8_BAR;
            }
        }
        if constexpr (ALIGN_EPI) { if (wr == 0) PG8_BAR; }
        if constexpr (!Epi::AFTER_DRAIN) { E(acc, cur, wr, wc, fr, fq); S.done(cur); }
        if (!has_next) break;
#pragma unroll
        for (int a = 0; a < 2; ++a)
#pragma unroll
            for (int b = 0; b < 2; ++b)
#pragma unroll
                for (int m = 0; m < 4; ++m)
#pragma unroll
                    for (int n = 0; n < 2; ++n) acc[a][b][m][n] = (f32x4){0.f, 0.f, 0.f, 0.f};
        cur = nxt; cA = nA; cB = nB; ++ui;
        if constexpr (ALIGN_EPI) { if (wr == 1) PG8_BAR; }
    }
    PG8_WAIT_V(0);
    if constexpr (!ALIGN_EPI) { if (wr == 0) PG8_BAR; }
    PG8_BAR;
    if constexpr (Epi::AFTER_DRAIN) { E.fused(acc, cur, wr, wc, fr, fq, lds, wid, lane); S.done(cur); }
#undef PG8_SA
#undef PG8_SB
#undef PG8_STAGE
#undef PG8_LDA
#undef PG8_LDB
#undef PG8_MMA
#undef PG8_WAIT_V
#undef PG8_WAIT_L
#undef PG8_BAR
#undef PG8_SCHED
}
}
namespace mk {
using pg8::bf16_t; using pg8::f32x4; using pg8::u32x4; using pg8::Unit;
#define LAS __attribute__((address_space(3)))
constexpr int D = 1024, NB = 2, L = 8192, M = NB * L, DEPTH = 2, FF = 2816, INW = 4104, INWP = 4352, H = 8, G = 32, P = 64, NG = 16, MODW = 9216;
constexpr int TC = 32, NCH = M / TC, UGK = 640;
constexpr int NWAVES = 8, NTHR = 512;
constexpr float LOG2E = 1.4426950408889634f;
constexpr float QSCALE = 0.125f * LOG2E;
constexpr size_t MiB = 1u << 20;
constexpr size_t WS_CTL = 0;
constexpr size_t WS_COEF = 1 * MiB;
constexpr size_t WS_MODP = 2 * MiB;
constexpr size_t WS_PW = 7 * MiB;
constexpr size_t WS_BB = WS_PW + (size_t)2 * 32 * 64 * 33 * 8;
constexpr size_t WS_KT = 9 * MiB;
constexpr size_t WS_WFI = 12 * MiB;
constexpr size_t WS_WFO = 34 * MiB;
constexpr size_t WS_WMI = 45 * MiB;
constexpr size_t WS_WGLU = 54 * MiB;
constexpr size_t WS_WAO = 56 * MiB;
constexpr size_t WS_WMO = 57 * MiB;
constexpr size_t WS_BTY = 59 * MiB;
constexpr size_t WS_BTF = 79 * MiB;
constexpr size_t WS_XN = 87 * MiB;
constexpr size_t WS_Y = 119 * MiB;
constexpr size_t WS_BIG = 183 * MiB;
constexpr size_t WS_AFFN = WS_BIG;
constexpr size_t WS_SGA = 183 * MiB, WS_SGB = 215 * MiB, WS_Q = 247 * MiB, WS_K = 263 * MiB, WS_V = 279 * MiB, WS_UG = 295 * MiB, WS_MERGED = 315 * MiB;
constexpr size_t WS_YS = 119 * MiB, WS_YBG = 135 * MiB, WS_LOCAL = 167 * MiB, WS_LF = 175 * MiB, WS_CUM = 176 * MiB;
constexpr size_t WS_END = 347 * MiB;
constexpr int RING_BYTES = 131072, LDS_BYTES = 147456;

typedef float f32x2 __attribute__((ext_vector_type(2)));
typedef unsigned u32x2 __attribute__((ext_vector_type(2)));
#define LDS_WAIT() asm volatile("s_waitcnt lgkmcnt(0)" ::: "memory")
__device__ __forceinline__ unsigned cvt_pk(float lo, float hi) { unsigned r; asm volatile("v_cvt_pk_bf16_f32 %0, %1, %2" : "=v"(r) : "v"(lo), "v"(hi)); return r; }
__device__ __forceinline__ float bf_lo(unsigned w) { return __uint_as_float(w << 16); }
__device__ __forceinline__ float bf_hi(unsigned w) { return __uint_as_float(w & 0xffff0000u); }
__device__ __forceinline__ float fast_sigmoid(float v) { return __builtin_amdgcn_rcpf(1.f + __builtin_amdgcn_exp2f(-LOG2E * v)); }
__device__ __forceinline__ float fast_silu(float v) { return v * fast_sigmoid(v); }
__device__ __forceinline__ float fast_gelu_tanh(float v) {
    const float z2 = 1.5957691216057308f * (v + 0.044715f * v * v * v); return v * fast_sigmoid(z2); }
__device__ __forceinline__ float wave_sum(float v) {
#pragma unroll
    for (int o = 1; o < 64; o <<= 1) v += __shfl_xor(v, o);
    return v;
}

template <class T> __device__ __forceinline__ T* launder(T* p) { asm volatile("" : "+s"(p)); return p; }
struct Args { const float* in[21]; float* out; unsigned char* ws; int n_sub; int pad; };
enum { I_X = 0, I_C, I_MODW, I_MODB, I_NPRE, I_NPOST, I_FWIN, I_FWOUT, I_MWIN, I_FB, I_ARE, I_AIM, I_LDT, I_BRE, I_BIM, I_CRE, I_CIM, I_SD, I_GLU, I_AO, I_MO };

struct EpiSwiglu {
    static constexpr bool PERM = true, AFTER_DRAIN = false;
    bf16_t* O; int ldc;
    __device__ __forceinline__ void operator()(const f32x4 (&acc)[2][2][4][2], const Unit& u, int wr, int wc, int fr, int fq) const {
        const int row0 = u.pm * 256 + wr * 64 + fr, col0 = u.pn * 128 + wc * 32 + 8 * fq;
#pragma unroll
        for (int ai = 0; ai < 2; ++ai)
#pragma unroll
            for (int m = 0; m < 4; ++m) {
                bf16_t* rowp = O + (size_t)(row0 + ai * 128 + m * 16) * ldc + col0;
                const f32x4 g0 = acc[ai][0][m][0], g1 = acc[ai][0][m][1], u0 = acc[ai][1][m][0], u1 = acc[ai][1][m][1];
                u32x4 w;
                w.x = cvt_pk(fast_silu(g0[0]) * u0[0], fast_silu(g0[1]) * u0[1]); w.y = cvt_pk(fast_silu(g0[2]) * u0[2], fast_silu(g0[3]) * u0[3]);
                w.z = cvt_pk(fast_silu(g1[0]) * u1[0], fast_silu(g1[1]) * u1[1]); w.w = cvt_pk(fast_silu(g1[2]) * u1[2], fast_silu(g1[3]) * u1[3]);
                *(u32x4*)rowp = w;
            }
    }
};
struct EpiF32 {
    static constexpr bool PERM = false, AFTER_DRAIN = false;
    float* C; int ldc;
    __device__ __forceinline__ void operator()(const f32x4 (&acc)[2][2][4][2], const Unit& u, int wr, int wc, int fr, int fq) const {
        const int row0 = u.pm * 256 + wr * 64 + fr, col0 = u.pn * 256 + wc * 32 + 4 * fq;
#pragma unroll
        for (int ai = 0; ai < 2; ++ai)
#pragma unroll
            for (int m = 0; m < 4; ++m) { float* rowp = C + (size_t)(row0 + ai * 128 + m * 16) * ldc + col0;
#pragma unroll
                for (int bj = 0; bj < 2; ++bj)
#pragma unroll
                    for (int n = 0; n < 2; ++n) *(f32x4*)(rowp + bj * 128 + n * 16) = acc[ai][bj][m][n]; }
    }
};

__device__ __forceinline__ void transpose_item(const float* __restrict__ W, int ldw, bf16_t* __restrict__ WT, int ldt, int k0, int src_col0, int dst_row0, int nvalid, LAS float* scr, int lane) {
    const int c0 = lane & 31;
#pragma unroll 8
    for (int i = 0; i < 32; ++i) { const int kk = 2 * i + (lane >> 5); scr[kk * 33 + c0] = (c0 < nvalid) ? W[(size_t)(k0 + kk) * ldw + src_col0 + c0] : 0.f; }
    LDS_WAIT(); asm volatile("" ::: "memory");
    const int c = lane & 7;
#pragma unroll
    for (int j = 0; j < 4; ++j) { const int n = (lane >> 3) + 8 * j; const LAS float* s = scr + (8 * c) * 33 + n;
        u32x4 o; o.x = cvt_pk(s[0 * 33], s[1 * 33]); o.y = cvt_pk(s[2 * 33], s[3 * 33]); o.z = cvt_pk(s[4 * 33], s[5 * 33]); o.w = cvt_pk(s[6 * 33], s[7 * 33]);
        *(u32x4*)(WT + (size_t)(dst_row0 + n) * ldt + k0 + 8 * c) = o; }
    LDS_WAIT(); asm volatile("" ::: "memory");
}
constexpr int CV_FI = 2 * 16 * 176, CV_FO = 2 * 44 * 32, CV_MI = 16 * 136, CV_GLU = 8 * 64, CV_AO = 8 * 32, CV_MO = 16 * 32, CV_TOTAL = CV_FI + CV_FO + CV_MI + CV_GLU + CV_AO + CV_MO;
__device__ __forceinline__ void conv_item(const Args& a, int l, int it, LAS float* scr, int lane) {
    unsigned char* ws = a.ws;
    if (it < CV_FI) { const int f = it / (16 * 176), r = it % (16 * 176), kb = r / 176, nb = r % 176, n0 = nb * 32, pn = n0 >> 8, w = n0 & 255;
        const int src = (w < 128) ? (128 * pn + w) : (FF + 128 * pn + (w - 128));
        transpose_item(a.in[I_FWIN] + (size_t)(l * 2 + f) * D * 2 * FF, 2 * FF, (bf16_t*)(ws + WS_WFI) + (size_t)f * 2 * FF * D, D, kb * 64, src, n0, 32, scr, lane); return; }
    it -= CV_FI;
    if (it < CV_FO) { const int f = it / (44 * 32), r = it % (44 * 32), kb = r / 32, nb = r % 32;
        transpose_item(a.in[I_FWOUT] + (size_t)(l * 2 + f) * FF * D, D, (bf16_t*)(ws + WS_WFO) + (size_t)f * D * FF, FF, kb * 64, nb * 32, nb * 32, 32, scr, lane); return; }
    it -= CV_FO;
    if (it < CV_MI) { const int kb = it / 136, nb = it % 136, n0 = nb * 32; int src, nv;
        if (n0 < 2048) { src = n0; nv = 32; } else if (n0 < 4096) { src = n0 + 8; nv = 32; } else if (n0 == 4096) { src = 2048; nv = 8; } else { src = 0; nv = 0; }
        transpose_item(a.in[I_MWIN] + (size_t)l * D * INW, INW, (bf16_t*)(ws + WS_WMI), D, kb * 64, src, n0, nv, scr, lane); return; }
    it -= CV_MI;
    if (it < CV_GLU) { const int kb = it / 64, nb = it % 64, n0 = nb * 32, pn = n0 >> 8, w = n0 & 255;
        const int src = (w < 128) ? (128 * pn + w) : (D + 128 * pn + (w - 128));
        transpose_item(a.in[I_GLU] + (size_t)l * 512 * 2048, 2048, (bf16_t*)(ws + WS_WGLU), 512, kb * 64, src, n0, 32, scr, lane); return; }
    it -= CV_GLU;
    if (it < CV_AO) { const int kb = it / 32, nb = it % 32;
        transpose_item(a.in[I_AO] + (size_t)l * 512 * D, D, (bf16_t*)(ws + WS_WAO), 512, kb * 64, nb * 32, nb * 32, 32, scr, lane); return; }
    it -= CV_AO;
    { const int kb = it / 32, nb = it % 32;
        transpose_item(a.in[I_MO] + (size_t)l * D * D, D, (bf16_t*)(ws + WS_WMO), D, kb * 64, nb * 32, nb * 32, 32, scr, lane); }
}
constexpr int MODP_ITEMS = 2 * 36 * 8;
__device__ __forceinline__ void modp_item(const Args& a, int it, int lane) {
    const int l = it / 288, r = it % 288, cgp = r / 8, kc = r % 8, j0 = cgp * 256 + lane * 4;
    const float* c = a.in[I_C]; const float* w = a.in[I_MODW] + ((size_t)l * D + kc * 128) * MODW + j0;
    f32x4 a0 = {0.f, 0.f, 0.f, 0.f}, a1 = {0.f, 0.f, 0.f, 0.f};
#pragma unroll 8
    for (int k = 0; k < 128; ++k) { const f32x4 wv = *(const f32x4*)(w + (size_t)k * MODW); const float c0 = c[kc * 128 + k], c1 = c[D + kc * 128 + k];
        const float s0 = c0 / (1.f + __expf(-c0)), s1 = c1 / (1.f + __expf(-c1)); a0 += wv * s0; a1 += wv * s1; }
    float* mp = (float*)(a.ws + WS_MODP) + (size_t)kc * 2 * 2 * MODW + (size_t)l * 2 * MODW + j0;
    *(f32x4*)mp = a0; *(f32x4*)(mp + MODW) = a1;
}
__device__ __forceinline__ void ssm_tables(const Args& a, int idx) {
    const int l = idx >> 11, gp = idx & 2047, g = gp >> 6;
    const float ar = fminf(a.in[I_ARE][idx], -1e-4f), ai = a.in[I_AIM][idx], dt = expf(a.in[I_LDT][l * G + g]);
    float sn, cs; sincosf(ai * dt, &sn, &cs);
    const float ea = expf(ar * dt), lr = ea * cs, li = ea * sn;
    const float sh = sinf(0.5f * ai * dt), nr = expm1f(ar * dt) * cs - 2.0f * sh * sh, ni = li, den = ar * ar + ai * ai;
    const float fr = (nr * ar + ni * ai) / den, fi = (ni * ar - nr * ai) / den;
    f32x2* pw = (f32x2*)(a.ws + WS_PW) + (size_t)idx * 33;
    double wr = 1.0, wi = 0.0; const double lrd = lr, lid = li;
    for (int t = 0; t < 33; ++t) { pw[t] = (f32x2){(float)wr, (float)wi}; const double nwr = wr * lrd - wi * lid, nwi = wr * lid + wi * lrd; wr = nwr; wi = nwi; }
    f32x2* bb = (f32x2*)(a.ws + WS_BB) + (size_t)idx * 16;
    const float* bre = a.in[I_BRE] + (size_t)idx * 16; const float* bim = a.in[I_BIM] + (size_t)idx * 16;
    for (int n = 0; n < 16; ++n) { const float br = bre[n], bi = bim[n]; bb[n] = (f32x2){fr * br - fi * bi, fr * bi + fi * br}; }
}
__device__ __forceinline__ void kt_entry(const Args& a, int idx) {
    const int ni = idx & 15, tau = (idx >> 4) & 31, no = (idx >> 9) & 15, lg = idx >> 13;
    const float* cre = a.in[I_CRE] + ((size_t)lg * 16 + no) * 64; const float* cim = a.in[I_CIM] + ((size_t)lg * 16 + no) * 64;
    const f32x2* pw = (const f32x2*)(a.ws + WS_PW) + (size_t)lg * 64 * 33 + tau; const f32x2* bb = (const f32x2*)(a.ws + WS_BB) + (size_t)lg * 64 * 16 + ni;
    float s = 0.f;
#pragma unroll 8
    for (int p = 0; p < 64; ++p) { const f32x2 w = pw[p * 33], b = bb[p * 16]; const float cr = cre[p], ci = cim[p];
        const float er = cr * w.x - ci * w.y, ei = cr * w.y + ci * w.x; s += er * b.x - ei * b.y; }
    ((float*)(a.ws + WS_KT))[idx] = s;
}
__device__ __forceinline__ void coef_entry(const Args& a, int idx) {
    const int d = idx & 1023, b = (idx >> 10) & 1, s = idx >> 11, l = s / 3, sub = s % 3;
    const float* mp = (const float*)(a.ws + WS_MODP) + (size_t)l * 2 * MODW + (size_t)b * MODW + sub * 3 * D + d;
    float sh = 0.f, sc = 0.f, gt = 0.f;
    for (int kc = 0; kc < 8; ++kc) { const float* q = mp + (size_t)kc * 4 * MODW; sh += q[0]; sc += q[D]; gt += q[2 * D]; }
    const float* mb = a.in[I_MODB] + (size_t)l * MODW + sub * 3 * D + d; sh += mb[0]; sc += mb[D]; gt += mb[2 * D];
    float* co = (float*)(a.ws + WS_COEF) + ((size_t)(s * 2 + b) * 3) * D + d;
    co[0] = (sub == 1 ? 1.0f : 0.5f) * gt * a.in[I_NPOST][s * D + d];
    co[D] = a.in[I_NPRE][s * D + d] * (1.f + sc);
    co[2 * D] = sh;
}
__device__ __forceinline__ void prenorm_row(const float* __restrict__ xrow, const float* __restrict__ cb, bf16_t* __restrict__ orow, int lane) {
    const f32x4* xr = (const f32x4*)xrow + lane; f32x4 v[4]; float ss = 0.f;
#pragma unroll
    for (int j = 0; j < 4; ++j) { v[j] = xr[64 * j]; ss += (v[j].x * v[j].x + v[j].y * v[j].y) + (v[j].z * v[j].z + v[j].w * v[j].w); }
    const float r = rsqrtf(wave_sum(ss) * (1.f / D) + 1e-6f);
    u32x2* o8 = (u32x2*)orow + lane;
#pragma unroll
    for (int j = 0; j < 4; ++j) { const f32x4 B = *((const f32x4*)cb + 64 * j + lane), C = *((const f32x4*)(cb + D) + 64 * j + lane); const f32x4 o = v[j] * r * B + C;
        u32x2 w; w.x = cvt_pk(o.x, o.y); w.y = cvt_pk(o.z, o.w); o8[64 * j] = w; }
}
__device__ __forceinline__ void postnorm_row(const float* __restrict__ xi, float* __restrict__ xo, const float* __restrict__ yrow, const float* __restrict__ ca, const float* __restrict__ cbn, bf16_t* __restrict__ xn, int lane) {
    f32x4 v[4], y[4]; float ss = 0.f;
#pragma unroll
    for (int j = 0; j < 4; ++j) { y[j] = *((const f32x4*)yrow + 64 * j + lane); v[j] = *((const f32x4*)xi + 64 * j + lane); ss += (y[j].x * y[j].x + y[j].y * y[j].y) + (y[j].z * y[j].z + y[j].w * y[j].w); }
    const float r = rsqrtf(wave_sum(ss) * (1.f / D) + 1e-6f); float s2 = 0.f;
#pragma unroll
    for (int j = 0; j < 4; ++j) { const f32x4 A = *((const f32x4*)ca + 64 * j + lane); v[j] = v[j] + A * (y[j] * r); *((f32x4*)xo + 64 * j + lane) = v[j];
        s2 += (v[j].x * v[j].x + v[j].y * v[j].y) + (v[j].z * v[j].z + v[j].w * v[j].w); }
    if (xn) { const float r2 = rsqrtf(wave_sum(s2) * (1.f / D) + 1e-6f); u32x2* o8 = (u32x2*)xn + lane;
#pragma unroll
        for (int j = 0; j < 4; ++j) { const f32x4 B = *((const f32x4*)cbn + 64 * j + lane), C = *((const f32x4*)(cbn + D) + 64 * j + lane); const f32x4 o = v[j] * r2 * B + C;
            u32x2 w; w.x = cvt_pk(o.x, o.y); w.y = cvt_pk(o.z, o.w); o8[64 * j] = w; } }
}
}
namespace mk {
__device__ __forceinline__ u32x4 pack8(const f32x4 a, const f32x4 b) { u32x4 w; w.x = cvt_pk(a[0], a[1]); w.y = cvt_pk(a[2], a[3]); w.z = cvt_pk(b[0], b[1]); w.w = cvt_pk(b[2], b[3]); return w; }
__device__ __forceinline__ void unpack8(const u32x4 w, f32x4& a, f32x4& b) { a = (f32x4){bf_lo(w.x), bf_hi(w.x), bf_lo(w.y), bf_hi(w.y)}; b = (f32x4){bf_lo(w.z), bf_hi(w.z), bf_lo(w.w), bf_hi(w.w)}; }
__device__ __forceinline__ float log2_sigmoid(float x) { return LOG2E * fminf(x, 0.f) - __builtin_amdgcn_logf(1.f + __builtin_amdgcn_exp2f(-LOG2E * fabsf(x))); }

struct EpiInProj {
    static constexpr bool PERM = true, AFTER_DRAIN = false;
    bf16_t *UG, *Q, *SGA; float* LF; const float* fb;
    static_assert(WS_K - WS_Q == 16 * MiB && WS_V - WS_K == 16 * MiB && WS_SGB - WS_SGA == 32 * MiB, "EpiInProj pointer arithmetic");
    __device__ __forceinline__ void operator()(const f32x4 (&acc)[2][2][4][2], const Unit& u, int wr, int wc, int fr, int fq) const {
        const int row0 = u.pm * 256 + wr * 64 + fr, pn = u.pn;
#pragma unroll
        for (int ai = 0; ai < 2; ++ai)
#pragma unroll
            for (int m = 0; m < 4; ++m) {
                const int row = row0 + ai * 128 + m * 16;
#pragma unroll
                for (int bj = 0; bj < 2; ++bj) {
                    const int c8 = 128 * bj + 32 * wc + 8 * fq; const f32x4 v0 = acc[ai][bj][m][0], v1 = acc[ai][bj][m][1];
                    if (pn < 2) { const int col = 256 * pn + c8, g = col >> 4, ch0 = col & 15, chunk = row >> 5, i = row & 31;
                        *(u32x4*)(UG + ((size_t)(g * NCH + chunk) * UGK + i * 16 + ch0)) = pack8(v0, v1); }
                    else if (pn < 8) { const int which = (pn - 2) >> 1, col = 256 * ((pn - 2) & 1) + c8; bf16_t* base = Q + (size_t)which * (16 * MiB / 2); const float sc = which == 0 ? QSCALE : 1.f;
                        *(u32x4*)(base + (size_t)row * 512 + col) = pack8(v0 * sc, v1 * sc); }
                    else if (pn < 16) { bf16_t* base = SGA + (size_t)(pn >= 12 ? 1 : 0) * (32 * MiB / 2); const int col = 256 * ((pn - 8) & 3) + c8;
                        f32x4 s0, s1;
#pragma unroll
                        for (int e = 0; e < 4; ++e) { s0[e] = fast_sigmoid(v0[e]); s1[e] = fast_sigmoid(v1[e]); }
                        *(u32x4*)(base + (size_t)row * 1024 + col) = pack8(s0, s1); }
                    else { if (bj == 0 && wc == 0 && fq == 0) { f32x4 l0, l1;
#pragma unroll
                            for (int e = 0; e < 4; ++e) { l0[e] = log2_sigmoid(v0[e] + fb[e]); l1[e] = log2_sigmoid(v1[e] + fb[4 + e]); }
                            *(f32x4*)(LF + (size_t)row * 8) = l0; *(f32x4*)(LF + (size_t)row * 8 + 4) = l1; } }
                }
            }
    }
};
struct EpiLocal {
    static constexpr bool PERM = false, AFTER_DRAIN = false;
    float* LOCAL;
    __device__ __forceinline__ void operator()(const f32x4 (&acc)[2][2][4][2], const Unit& u, int wr, int wc, int fr, int fq) const {
        const int g = u.pn, chunk0 = (u.pm & 1) * 256 + wr * 64 + fr;
#pragma unroll
        for (int ai = 0; ai < 2; ++ai)
#pragma unroll
            for (int m = 0; m < 4; ++m) { float* rowp = LOCAL + ((size_t)(chunk0 + ai * 128 + m * 16) * G + g) * 128 + wc * 32 + 4 * fq;
#pragma unroll
                for (int n = 0; n < 2; ++n) *(f32x4*)(rowp + n * 16) = acc[ai][0][m][n]; }
    }
};
struct EpiSsmY {
    static constexpr bool PERM = true, AFTER_DRAIN = false;
    const bf16_t* UG; bf16_t* YS; const float* dsk;
    __device__ __forceinline__ void operator()(const f32x4 (&acc)[2][2][4][2], const Unit& u, int wr, int wc, int fr, int fq) const {
        const int g = u.pm >> 1, nj = u.pn & 1, chunk0 = (u.pm & 1) * 256 + wr * 64 + fr, no0 = 8 * (fq & 1);
        const f32x4 d0 = *(const f32x4*)(dsk + g * 16 + no0), d1 = *(const f32x4*)(dsk + g * 16 + no0 + 4);
#pragma unroll
        for (int ai = 0; ai < 2; ++ai)
#pragma unroll
            for (int m = 0; m < 4; ++m) { const int chunk = chunk0 + ai * 128 + m * 16;
#pragma unroll
                for (int bj = 0; bj < 2; ++bj) { const int j = nj * 16 + 8 * bj + 2 * wc + (fq >> 1);
                    const u32x4 uw = *(const u32x4*)(UG + ((size_t)(g * NCH + chunk) * UGK + j * 16 + no0)); f32x4 u0, u1; unpack8(uw, u0, u1);
                    f32x4 y0 = acc[ai][bj][m][0] + d0 * u0, y1 = acc[ai][bj][m][1] + d1 * u1;
#pragma unroll
                    for (int e = 0; e < 4; ++e) { y0[e] = fast_gelu_tanh(y0[e]); y1[e] = fast_gelu_tanh(y1[e]); }
                    *(u32x4*)(YS + ((size_t)(chunk * TC + j) * 512 + g * 16 + no0)) = pack8(y0, y1); } }
    }
};
struct EpiAO {
    static constexpr bool PERM = true, AFTER_DRAIN = false;
    const bf16_t* SGB; bf16_t* YBG;
    __device__ __forceinline__ void operator()(const f32x4 (&acc)[2][2][4][2], const Unit& u, int wr, int wc, int fr, int fq) const {
        const int row0 = u.pm * 256 + wr * 64 + fr, col0 = u.pn * 256 + wc * 32 + 8 * fq;
#pragma unroll
        for (int ai = 0; ai < 2; ++ai)
#pragma unroll
            for (int m = 0; m < 4; ++m)
#pragma unroll
                for (int bj = 0; bj < 2; ++bj) { const size_t off = (size_t)(row0 + ai * 128 + m * 16) * D + col0 + bj * 128;
                    f32x4 s0, s1; unpack8(*(const u32x4*)(SGB + off), s0, s1);
                    *(u32x4*)(YBG + off) = pack8(acc[ai][bj][m][0] * s0, acc[ai][bj][m][1] * s1); }
    }
};
struct EpiGLU {
    static constexpr bool PERM = true, AFTER_DRAIN = false;
    const bf16_t *SGA, *YBG; bf16_t* MG;
    __device__ __forceinline__ void operator()(const f32x4 (&acc)[2][2][4][2], const Unit& u, int wr, int wc, int fr, int fq) const {
        const int row0 = u.pm * 256 + wr * 64 + fr, col0 = u.pn * 128 + wc * 32 + 8 * fq;
#pragma unroll
        for (int ai = 0; ai < 2; ++ai)
#pragma unroll
            for (int m = 0; m < 4; ++m) { const size_t off = (size_t)(row0 + ai * 128 + m * 16) * D + col0;
                f32x4 s0, s1, b0, b1; unpack8(*(const u32x4*)(SGA + off), s0, s1); unpack8(*(const u32x4*)(YBG + off), b0, b1);
                const f32x4 v0 = acc[ai][0][m][0], v1 = acc[ai][0][m][1], g0 = acc[ai][1][m][0], g1 = acc[ai][1][m][1]; f32x4 o0, o1;
#pragma unroll
                for (int e = 0; e < 4; ++e) { o0[e] = v0[e] * fast_sigmoid(g0[e]) * s0[e] + b0[e]; o1[e] = v1[e] * fast_sigmoid(g1[e]) * s1[e] + b1[e]; }
                *(u32x4*)(MG + off) = pack8(o0, o1); }
    }
};
struct LocalOrder { int c; __device__ __forceinline__ bool next(int i, Unit& u) const { if (i > 0 || c < 0 || c >= 64) return false; u.pm = c; u.pn = c >> 1; return true; }
    __device__ __forceinline__ void a_ready(const Unit&) const {} __device__ __forceinline__ void done(const Unit&) const {} };
struct SsmYOrder { int c; __device__ __forceinline__ bool next(int i, Unit& u) const { if (i > 0 || c < 0 || c >= 128) return false; const int g = c >> 2; u.pm = g * 2 + ((c >> 1) & 1); u.pn = g * 2 + (c & 1); return true; }
    __device__ __forceinline__ void a_ready(const Unit&) const {} __device__ __forceinline__ void done(const Unit&) const {} };

__device__ __forceinline__ void ssm_mat_item(const Args& a, int l, int r, int lane) {
    unsigned char* ws = a.ws;
    const f32x2* PWt = (const f32x2*)(ws + WS_PW); const f32x2* BBt = (const f32x2*)(ws + WS_BB); const float* KT = (const float*)(ws + WS_KT);
    if (r < 16384) {
        const int g = r >> 9, j = (r >> 4) & 31, no = r & 15, lg = l * 32 + g;
        bf16_t* dst = (bf16_t*)(ws + WS_BTY) + (size_t)r * UGK;
        { const int i = lane >> 1, ni0 = (lane & 1) * 8; u32x4 w = {0u, 0u, 0u, 0u};
          if (i <= j) { const float* src = KT + ((((size_t)lg * 16 + no) * 32 + (j - i)) * 16 + ni0); w = pack8(*(const f32x4*)src, *(const f32x4*)(src + 4)); }
          *(u32x4*)(dst + 8 * lane) = w; }
        if (lane < 16) { const int part = lane >> 3, p0 = (lane & 7) * 8; float v[8];
#pragma unroll
            for (int e = 0; e < 8; ++e) { const int p = p0 + e; const float cr = a.in[I_CRE][((size_t)lg * 16 + no) * 64 + p], ci = a.in[I_CIM][((size_t)lg * 16 + no) * 64 + p]; const f32x2 w = PWt[((size_t)lg * 64 + p) * 33 + j + 1];
                v[e] = part ? -(cr * w.y + ci * w.x) : (cr * w.x - ci * w.y); }
            *(u32x4*)(dst + 512 + 8 * lane) = pack8((f32x4){v[0], v[1], v[2], v[3]}, (f32x4){v[4], v[5], v[6], v[7]}); }
    } else {
        r -= 16384;
        const int g = r >> 8, rr = r & 255, lg = l * 32 + g;
        bf16_t* dst = (bf16_t*)(ws + WS_BTF) + (size_t)r * 512;
        u32x4 w = {0u, 0u, 0u, 0u};
        if (rr < 128) { const int p = rr & 63, part = rr >> 6, i = lane >> 1, ni0 = (lane & 1) * 8; const f32x2 pw = PWt[((size_t)lg * 64 + p) * 33 + 31 - i]; float v[8];
#pragma unroll
            for (int e = 0; e < 8; ++e) { const f32x2 bb = BBt[((size_t)lg * 64 + p) * 16 + ni0 + e]; v[e] = part ? (pw.x * bb.y + pw.y * bb.x) : (pw.x * bb.x - pw.y * bb.y); }
            w = pack8((f32x4){v[0], v[1], v[2], v[3]}, (f32x4){v[4], v[5], v[6], v[7]}); }
        *(u32x4*)(dst + 8 * lane) = w;
    }
}
constexpr int SSM_MAT_ITEMS = 16384 + 8192;

__device__ __forceinline__ void cum_block(const float* __restrict__ LF, float* __restrict__ CUM, int bh, LAS float* red, int tid) {
    const int b = bh >> 3, h = bh & 7, t0 = tid * 16, lane = tid & 63, wv = tid >> 6;
    const float* lf = LF + ((size_t)b * L + t0) * 8 + h;
    float v[16]; float s = 0.f;
#pragma unroll
    for (int i = 0; i < 16; ++i) { v[i] = lf[i * 8]; s += v[i]; }
    float inc = s;
#pragma unroll
    for (int o = 1; o < 64; o <<= 1) { const float t = __shfl_up(inc, o); if (lane >= o) inc += t; }
    if (lane == 63) red[wv] = inc;
    __syncthreads();
    float base = 0.f;
#pragma unroll
    for (int w = 0; w < 8; ++w) base += (w < wv) ? red[w] : 0.f;
    float run = base + inc - s;
    float* dst = CUM + (size_t)bh * L + t0;
#pragma unroll
    for (int i = 0; i < 16; i += 4) { f32x4 o; run += v[i]; o[0] = run; run += v[i + 1]; o[1] = run; run += v[i + 2]; o[2] = run; run += v[i + 3]; o[3] = run; *(f32x4*)(dst + i) = o; }
    __syncthreads();
}
__device__ __forceinline__ void carry_scan(const Args& a, int l, int idx) {
    const int b = idx >> 11, g = (idx >> 6) & 31, p = idx & 63;
    const f32x2 aw = ((const f32x2*)(a.ws + WS_PW))[((size_t)(l * 32 + g) * 64 + p) * 33 + 32];
    const float* loc = (const float*)(a.ws + WS_LOCAL) + ((size_t)(b * 256) * G + g) * 128 + p;
    bf16_t* ug = (bf16_t*)(a.ws + WS_UG) + ((size_t)(g * NCH + b * 256)) * UGK + 512 + p;
    float sr = 0.f, si = 0.f;
#pragma unroll 8
    for (int c = 0; c < 256; ++c) {
        const float lr = loc[(size_t)c * G * 128], li = loc[(size_t)c * G * 128 + 64];
        ug[(size_t)c * UGK] = (bf16_t)(cvt_pk(sr, 0.f) & 0xffffu); ug[(size_t)c * UGK + 64] = (bf16_t)(cvt_pk(si, 0.f) & 0xffffu);
        const float nr = aw.x * sr - aw.y * si + lr, ni = aw.x * si + aw.y * sr + li; sr = nr; si = ni;
    }
}
}
#include <hip/hip_bf16.h>
#include <cmath>
namespace attn_body {
using bf16=__hip_bfloat16;
using bf16x8=__attribute__((ext_vector_type(8)))short;
using s16x4=__attribute__((ext_vector_type(4)))short;
using f32x16=__attribute__((ext_vector_type(16)))float;
using u32x4=__attribute__((ext_vector_type(4)))unsigned;
constexpr int BATCH=2,NHEAD=8,SEQ=8192,D=64,DM=NHEAD*D;
constexpr int NW=8,QBLK=32,QB=QBLK*NW,KVBLK=64,NQB=SEQ/QB;
constexpr int ATTN_PITCH=DM, ATTN_UNIT_ROWS=QB;
__device__ __forceinline__ int crow(int r,int hi){return (r&3)+8*(r>>2)+4*hi;}
#define SBAR() __builtin_amdgcn_sched_barrier(0)
__device__ __forceinline__ void cmask(f32x16&p0,f32x16&p1,int jb,int qrel,int hi){
  const float NEG=-INFINITY; int kb=64*jb+4*hi;
  #pragma unroll
  for(int r=0;r<16;++r){int kv=kb+(r&3)+8*(r>>2); if(kv>qrel)p0[r]=NEG; if(kv+32>qrel)p1[r]=NEG;}
}

constexpr int NSLOT=3, SLOTB=8192;
constexpr int LDS_K=0, LDS_V=NSLOT*SLOTB, LDS_WS=2*NSLOT*SLOTB, LDS_OST=LDS_WS+NW*64*4, LDS_CK=LDS_OST+NW*4096, LDS_BYTES=LDS_CK+SEQ*4;
constexpr float C2=0.125f*1.4426950408889634f;
__device__ __forceinline__ void glds16(const void*gsrc,unsigned lds_dst){unsigned keep;
  asm volatile("s_mov_b32 %0, m0\n\ts_mov_b32 m0, %2\n\ts_nop 0\n\tglobal_load_lds_dwordx4 %1, off\n\ts_mov_b32 m0, %0":"=&s"(keep):"v"(gsrc),"s"(lds_dst):"memory");}
__device__ __forceinline__ float max3f(float a,float b,float c){float r;asm("v_max3_f32 %0, %1, %2, %3":"=v"(r):"v"(a),"v"(b),"v"(c));return r;}
__device__ __forceinline__ float max2f(float a,float b){float r;asm("v_max_f32_e32 %0, %1, %2":"=v"(r):"v"(a),"v"(b));return r;}
__device__ __forceinline__ float fadd_s(float a,float b){float r;asm("v_add_f32_e32 %0, %1, %2":"=v"(r):"v"(a),"v"(b));return r;}
__device__ __forceinline__ float fsub_s(float a,float b){float r;asm("v_sub_f32_e32 %0, %1, %2":"=v"(r):"v"(a),"v"(b));return r;}
typedef float f32x2_t __attribute__((ext_vector_type(2))); typedef __bf16 bf16x2_t __attribute__((ext_vector_type(2)));
__device__ __forceinline__ unsigned cvtpk_s(float lo,float hi){f32x2_t v={lo,hi};bf16x2_t b=__builtin_convertvector(v,bf16x2_t);return __builtin_bit_cast(unsigned,b);}
#define WAIT_BAR(N) asm volatile("s_waitcnt vmcnt(" #N ") lgkmcnt(0)\n\ts_barrier":::"memory")

__device__ __forceinline__ void qkt(f32x16&p0,f32x16&p1,const char*Kslot,const bf16x8*qr,bf16x8 ka0,bf16x8 ka1,bf16x8 qaug,int r32,int hi){
  const char*kb=Kslot+hi*1024+r32*16;
  const f32x16 z=f32x16{};
  #pragma unroll
  for(int d0=0;d0<4;++d0){
    const bf16x8 b0=*reinterpret_cast<const bf16x8*>(kb+d0*2048);
    const bf16x8 b1=*reinterpret_cast<const bf16x8*>(kb+d0*2048+512);
    if(d0==0){p0=__builtin_amdgcn_mfma_f32_32x32x16_bf16(b0,qr[0],z,0,0,0);p1=__builtin_amdgcn_mfma_f32_32x32x16_bf16(b1,qr[0],z,0,0,0);}
    else{p0=__builtin_amdgcn_mfma_f32_32x32x16_bf16(b0,qr[d0],p0,0,0,0);p1=__builtin_amdgcn_mfma_f32_32x32x16_bf16(b1,qr[d0],p1,0,0,0);}}
  p0=__builtin_amdgcn_mfma_f32_32x32x16_bf16(ka0,qaug,p0,0,0,0);p1=__builtin_amdgcn_mfma_f32_32x32x16_bf16(ka1,qaug,p1,0,0,0);
}
typedef __attribute__((address_space(3))) const char* lds_cptr;
typedef short v4i16_t __attribute__((ext_vector_type(4)));
__device__ __forceinline__ void kload8(bf16x8*kf,lds_cptr kp){
  kf[0]=*(const __attribute__((address_space(3))) bf16x8*)(kp);      kf[1]=*(const __attribute__((address_space(3))) bf16x8*)(kp+512);
  kf[2]=*(const __attribute__((address_space(3))) bf16x8*)(kp+2048); kf[3]=*(const __attribute__((address_space(3))) bf16x8*)(kp+2560);
  kf[4]=*(const __attribute__((address_space(3))) bf16x8*)(kp+4096); kf[5]=*(const __attribute__((address_space(3))) bf16x8*)(kp+4608);
  kf[6]=*(const __attribute__((address_space(3))) bf16x8*)(kp+6144); kf[7]=*(const __attribute__((address_space(3))) bf16x8*)(kp+6656);
}
__device__ __forceinline__ void kload2(bf16x8*kf,lds_cptr kp,int j){ kf[2*j]=*(const __attribute__((address_space(3))) bf16x8*)(kp+j*2048); kf[2*j+1]=*(const __attribute__((address_space(3))) bf16x8*)(kp+j*2048+512); }
__device__ __forceinline__ s16x4 vtr(lds_cptr p){ return __builtin_bit_cast(s16x4,__builtin_amdgcn_ds_read_tr16_b64_v4i16((__attribute__((address_space(3))) v4i16_t*)p)); }
__device__ __forceinline__ float rowmax(const f32x16&p0,const f32x16&p1){
  float a=max3f(p0[0],p0[1],p1[0]),b=max3f(p0[2],p0[3],p1[1]);a=max3f(a,p1[2],p1[3]);
  #pragma unroll
  for(int r=4;r<16;r+=4){a=max3f(a,p0[r],p0[r+1]);b=max3f(b,p0[r+2],p0[r+3]);a=max3f(a,p1[r],p1[r+1]);b=max3f(b,p1[r+2],p1[r+3]);}
  const float m=max2f(a,b);
  auto rr=__builtin_amdgcn_permlane32_swap(__float_as_uint(m),__float_as_uint(m),false,false);
  return max2f(__uint_as_float(rr[0]),__uint_as_float(rr[1]));
}
__device__ __forceinline__ void pv(f32x16*o,int vb,bf16x8 pa0,bf16x8 pa1,bf16x8 pa2,bf16x8 pa3){
  #pragma unroll
  for(int d0=0;d0<2;++d0){s16x4 lo[4],hi[4];
    #pragma unroll
    for(int ks=0;ks<4;++ks){
      asm volatile("ds_read_b64_tr_b16 %0,%1 offset:%c2":"=&v"(lo[ks]):"v"(vb),"i"(d0*4096+ks*1024):"memory");
      asm volatile("ds_read_b64_tr_b16 %0,%1 offset:%c2":"=&v"(hi[ks]):"v"(vb),"i"(d0*4096+ks*1024+512):"memory");}
    asm volatile("s_waitcnt lgkmcnt(0)":::"memory");SBAR();
    #define PK(k) (bf16x8){lo[k][0],lo[k][1],lo[k][2],lo[k][3],hi[k][0],hi[k][1],hi[k][2],hi[k][3]}
    o[d0]=__builtin_amdgcn_mfma_f32_32x32x16_bf16(pa0,PK(0),o[d0],0,0,0);
    o[d0]=__builtin_amdgcn_mfma_f32_32x32x16_bf16(pa1,PK(1),o[d0],0,0,0);
    o[d0]=__builtin_amdgcn_mfma_f32_32x32x16_bf16(pa2,PK(2),o[d0],0,0,0);
    o[d0]=__builtin_amdgcn_mfma_f32_32x32x16_bf16(pa3,PK(3),o[d0],0,0,0);
    #undef PK
  }
}

#ifndef ATTN_STORE16
#define ATTN_STORE16(p,v) (*(u32x4*)(p)=(v))
#endif
template<int THRL> __device__ __forceinline__ void attn_unit(int b,int h,int qb,const bf16*Q,const bf16*__restrict__ K,const bf16*__restrict__ V,bf16*O,const float*__restrict__ CUM,char*shm){
  int tid_=threadIdx.x; asm volatile("":"+v"(tid_)); const int tid=tid_,lane=tid&63,r32=lane&31,hi=lane>>5; const int wid=__builtin_amdgcn_readfirstlane(tid>>6);
  const long rowbase=(long)b*SEQ; const int q0=qb*QB;
  const bf16*Qw=Q+(rowbase+q0+wid*QBLK)*DM+h*D;
  const bf16*Kh=K+rowbase*DM+h*D,*Vh=V+rowbase*DM+h*D;
  const unsigned lds0=(unsigned)(uintptr_t)shm;
  float*wsf=(float*)(shm+LDS_WS)+wid*64;
  const bf16*ksrc=Kh+(long)lane*DM+wid*8;
  const bf16*vsrc=Vh+(long)(16*(wid&3)+(lane>>2))*DM+(wid>>2)*32+(lane&3)*8;
  const unsigned kdst=lds0+LDS_K+wid*1024, vdst=lds0+LDS_V+wid*1024;
  #define DMA_K(t,slot) glds16(ksrc+(long)(t)*KVBLK*DM,(unsigned)__builtin_amdgcn_readfirstlane(kdst+(slot)))
  #define DMA_V(t,slot) glds16(vsrc+(long)(t)*KVBLK*DM,(unsigned)__builtin_amdgcn_readfirstlane(vdst+(slot)))
  const int vb0=(int)(lds0+LDS_V)+((lane>>4)&1)*32+(lane&3)*8+(4*hi+((lane&15)>>2))*64;
  const char*Kbase=shm+LDS_K; bf16x8 kf[8];
  const lds_cptr shm3=(lds_cptr)shm; const lds_cptr kp0=shm3+LDS_K+hi*1024+r32*16; const lds_cptr vp0=shm3+LDS_V+((lane>>4)&1)*32+(lane&3)*8+(4*hi+((lane&15)>>2))*64;
  const int NT=(q0+QB)/KVBLK;
  const __attribute__((address_space(3))) unsigned* ckp=(const __attribute__((address_space(3))) unsigned*)(shm3+LDS_CK);
  { const float*cb=CUM+((long)b*NHEAD+h)*SEQ; const float cref=cb[q0];
    for(int i=tid;i<q0+QB;i+=512){ const float rel=cb[i]-cref; const unsigned hb=cvtpk_s(rel,0.f)&0xffffu; const float hf=__uint_as_float(hb<<16); const unsigned lb=cvtpk_s(rel-hf,0.f)&0xffffu;
      ((__attribute__((address_space(3))) unsigned*)(shm3+LDS_CK))[i]=hb|(lb<<16); }
    asm volatile("s_waitcnt vmcnt(0) lgkmcnt(0)":::"memory"); }
  const unsigned one2=hi?0u:0x3f803f80u, neg2=hi?0u:0xbf80bf80u;
  #define KAUG(w) __builtin_bit_cast(bf16x8,(u32x4){hi?0u:(w),one2,0u,0u})
  #define QAUG() __builtin_bit_cast(bf16x8,(u32x4){neg2,mpk,0u,0u})
  unsigned mpk=0u;
  #define SETM(m) do{ const unsigned hb_=cvtpk_s(m,0.f)&0xffffu; const float hf_=__uint_as_float(hb_<<16); const unsigned lb_=cvtpk_s((m)-hf_,0.f)&0xffffu; const float lf_=__uint_as_float(lb_<<16); \
      m=hf_+lf_; mpk=hi?0u:((hb_|(lb_<<16))^0x80008000u); }while(0)
  DMA_K(0,0);DMA_V(0,0);DMA_K(1,SLOTB);
  bf16x8 qr[4];
  #pragma unroll
  for(int d0=0;d0<4;++d0)qr[d0]=*reinterpret_cast<const bf16x8*>(&Qw[(long)r32*DM+d0*16+hi*8]);
  float mhat=0.f,l_reg=0.f;f32x16 o[2];o[0]=f32x16{};o[1]=f32x16{};
  const int qrel=wid*QBLK+r32;
  #define CMASK(P0,P1,t) do{int jb_=(t)-(NT-4); if(jb_>=0)cmask(P0,P1,jb_,qrel,hi);}while(0)
  bool resc=false;
  #define START(P0,P1) do{ const float rm=rowmax(P0,P1); resc=false; \
    { mhat=rm; SETM(mhat); const float dl=mhat; \
      _Pragma("unroll") for(int r=0;r<16;++r){P0[r]=fsub_s(P0[r],dl);P1[r]=fsub_s(P1[r],dl);} } \
    _Pragma("unroll") for(int r=0;r<16;++r)P0[r]=__builtin_amdgcn_exp2f(P0[r]); }while(0)
  #define RESC() do{ if(resc){ asm volatile("s_waitcnt lgkmcnt(0)":::"memory"); \
      _Pragma("unroll") for(int d_=0;d_<2;++d_) _Pragma("unroll") for(int r=0;r<16;++r)o[d_][r]*=wsf[crow(r,hi)]; } }while(0)
  f32x16 pA0,pA1,pB0,pB1;
  int sl_prev=0,sl_cur=0,sl_next=SLOTB;
  #define ROT() do{sl_prev=sl_cur;sl_cur=sl_next;sl_next=(sl_next==(NSLOT-1)*SLOTB)?0:sl_next+SLOTB;}while(0)
  DMA_K(2,2*SLOTB);
  WAIT_BAR(3);
  { const unsigned w0=ckp[r32],w1=ckp[32+r32]; qkt(pA0,pA1,Kbase,qr,KAUG(w0),KAUG(w1),QAUG(),r32,hi); }asm volatile("s_nop 15\n\ts_nop 7":"+v"(pA0),"+v"(pA1));CMASK(pA0,pA1,0);
  START(pA0,pA1);
  _Pragma("unroll") for(int r=0;r<16;++r)pA1[r]=__builtin_amdgcn_exp2f(pA1[r]);
  WAIT_BAR(0);
  DMA_K(3,0);DMA_V(1,SLOTB);
  ROT();
  kload8(kf,kp0+sl_cur);
  WAIT_BAR(2);
  s16x4 vlo[8],vhi[8]; u32x4 pw0,pw1,pw2,pw3;
  #define PKW(P,B) cvtpk_s(P[B],P[B+1])
  #define PAF(k) __builtin_bit_cast(bf16x8,pw##k)
  #define VFR(i) (bf16x8){vlo[i][0],vlo[i][1],vlo[i][2],vlo[i][3],vhi[i][0],vhi[i][1],vhi[i][2],vhi[i][3]}
  #define PIN(x) asm volatile("":"+v"(x))
  #define MX3(a,b,c) __builtin_fmaxf(__builtin_fmaxf((a),(b)),(c))
  #define GAPA(MF,A0,A1,A2,A3,W0,W1,PW) do{ MF; sacc+=A0; sacc+=A1; sacc+=A2; sacc+=A3; PIN(sacc); W0; W1; PIN(PW); SBAR(); }while(0)
  #define EX(v) __builtin_amdgcn_exp2f(v)
  #define GAPB(MF,X,B) do{ MF; X[B]=EX(X[B]); X[B+1]=EX(X[B+1]); X[B+2]=EX(X[B+2]); X[B+3]=EX(X[B+3]); PIN(X); SBAR(); }while(0)
  #define VRD(i) do{ vlo[i]=vtr(vp_+(((i)>>2)*4096+((i)&3)*1024)); vhi[i]=vtr(vp_+(((i)>>2)*4096+((i)&3)*1024+512)); }while(0)
  #define KRD(G,j) do{ if(G){ kload2(kf,kp0+sl_next,j); SBAR(); } }while(0)
  #define STEP(C0,C1,P0,P1,t,GK,GV,GL) do{ SBAR(); \
    const lds_cptr vp_=vp0+sl_prev; \
    const unsigned cw0_=ckp[(t)*64+r32],cw1_=ckp[(t)*64+32+r32]; const f32x16 z_=f32x16{}; \
    VRD(0); SBAR(); float sacc=(P0[0]+P0[1]); \
    GAPA(C0=__builtin_amdgcn_mfma_f32_32x32x16_bf16(kf[0],qr[0],z_,0,0,0), P0[2],P0[3],P0[4],P0[5],     pw0[0]=PKW(P0,0), pw0[1]=PKW(P0,2), pw0); \
    VRD(4); SBAR(); GAPA(C1=__builtin_amdgcn_mfma_f32_32x32x16_bf16(kf[1],qr[0],z_,0,0,0), P0[6],P0[7],P0[8],P0[9],     pw0[2]=PKW(P0,4), pw0[3]=PKW(P0,6), pw0); \
    VRD(1); SBAR(); GAPA(C0=__builtin_amdgcn_mfma_f32_32x32x16_bf16(kf[2],qr[1],C0,0,0,0),   P0[10],P0[11],P0[12],P0[13], pw1[0]=PKW(P0,8), pw1[1]=PKW(P0,10), pw1); \
    VRD(5); SBAR(); GAPA(C1=__builtin_amdgcn_mfma_f32_32x32x16_bf16(kf[3],qr[1],C1,0,0,0),   P0[14],P0[15],P1[0],P1[1],   pw1[2]=PKW(P0,12),pw1[3]=PKW(P0,14), pw1); \
    VRD(2); SBAR(); GAPA(C0=__builtin_amdgcn_mfma_f32_32x32x16_bf16(kf[4],qr[2],C0,0,0,0),   P1[2],P1[3],P1[4],P1[5],     pw2[0]=PKW(P1,0), pw2[1]=PKW(P1,2), pw2); \
    VRD(6); SBAR(); GAPA(C1=__builtin_amdgcn_mfma_f32_32x32x16_bf16(kf[5],qr[2],C1,0,0,0),   P1[6],P1[7],P1[8],P1[9],     pw2[2]=PKW(P1,4), pw2[3]=PKW(P1,6), pw2); \
    VRD(3); SBAR(); GAPA(C0=__builtin_amdgcn_mfma_f32_32x32x16_bf16(kf[6],qr[3],C0,0,0,0),   P1[10],P1[11],P1[12],P1[13], pw3[0]=PKW(P1,8), pw3[1]=PKW(P1,10), pw3); \
    VRD(7); SBAR(); GAPA(C1=__builtin_amdgcn_mfma_f32_32x32x16_bf16(kf[7],qr[3],C1,0,0,0),   P1[14],P1[15],0.f,0.f,       pw3[2]=PKW(P1,12),pw3[3]=PKW(P1,14), pw3); \
    C0=__builtin_amdgcn_mfma_f32_32x32x16_bf16(KAUG(cw0_),QAUG(),C0,0,0,0); C1=__builtin_amdgcn_mfma_f32_32x32x16_bf16(KAUG(cw1_),QAUG(),C1,0,0,0); SBAR(); \
    l_reg+=sacc; \
    if(GK){DMA_K((t)+3,sl_cur);} if(GV){DMA_V((t)+1,sl_next);} \
    CMASK(C0,C1,t); \
    { float a=MX3(C0[0],C0[1],C1[0]),b=MX3(C0[2],C0[3],C1[1]); a=MX3(a,C1[2],C1[3]); \
      _Pragma("unroll") for(int r=4;r<16;r+=4){a=MX3(a,C0[r],C0[r+1]);b=MX3(b,C0[r+2],C0[r+3]);a=MX3(a,C1[r],C1[r+1]);b=MX3(b,C1[r+2],C1[r+3]);} \
      float rm=__builtin_fmaxf(a,b); { auto rr=__builtin_amdgcn_permlane32_swap(__float_as_uint(rm),__float_as_uint(rm),false,false); rm=__builtin_fmaxf(__uint_as_float(rr[0]),__uint_as_float(rr[1])); } \
      resc=false; \
      if(__builtin_expect(__any(rm>(float)THRL),0)){ const float mold_=mhat; mhat+=__builtin_fmaxf(rm,0.f); SETM(mhat); const float dl=mhat-mold_; \
        _Pragma("unroll") for(int r=0;r<16;++r){C0[r]-=dl;C1[r]-=dl;} \
        const float f=__builtin_amdgcn_exp2f(-dl); l_reg*=f; if(hi==0)wsf[r32]=f; resc=true; } } \
    SBAR(); \
    GAPB(o[0]=__builtin_amdgcn_mfma_f32_32x32x16_bf16(PAF(0),VFR(0),o[0],0,0,0), C0,0); \
    GAPB(o[1]=__builtin_amdgcn_mfma_f32_32x32x16_bf16(PAF(0),VFR(4),o[1],0,0,0), C0,4); \
    KRD(GL,0); GAPB(o[0]=__builtin_amdgcn_mfma_f32_32x32x16_bf16(PAF(1),VFR(1),o[0],0,0,0), C0,8); \
    KRD(GL,1); GAPB(o[1]=__builtin_amdgcn_mfma_f32_32x32x16_bf16(PAF(1),VFR(5),o[1],0,0,0), C0,12); \
    KRD(GL,2); GAPB(o[0]=__builtin_amdgcn_mfma_f32_32x32x16_bf16(PAF(2),VFR(2),o[0],0,0,0), C1,0); \
    KRD(GL,3); GAPB(o[1]=__builtin_amdgcn_mfma_f32_32x32x16_bf16(PAF(2),VFR(6),o[1],0,0,0), C1,4); \
    GAPB(o[0]=__builtin_amdgcn_mfma_f32_32x32x16_bf16(PAF(3),VFR(3),o[0],0,0,0), C1,8); \
    GAPB(o[1]=__builtin_amdgcn_mfma_f32_32x32x16_bf16(PAF(3),VFR(7),o[1],0,0,0), C1,12); \
    }while(0)
  int t=1;
  #undef CMASK
  #define CMASK(P0,P1,t) do{}while(0)
  for(;t+5<NT;t+=2){
    STEP(pB0,pB1,pA0,pA1,t,true,true,true);     WAIT_BAR(2); RESC(); ROT();
    STEP(pA0,pA1,pB0,pB1,t+1,true,true,true);   WAIT_BAR(2); RESC(); ROT();
  }
  #undef CMASK
  #define CMASK(P0,P1,t) do{int jb_=(t)-(NT-4); if(jb_>=0)cmask(P0,P1,jb_,qrel,hi);}while(0)
  #define ENDW(tt) do{ if((tt)+3<NT){WAIT_BAR(2);} else if((tt)+2<NT){WAIT_BAR(1);} else {WAIT_BAR(0);} }while(0)
  for(;t+1<NT;t+=2){
    STEP(pB0,pB1,pA0,pA1,t,(t+3<NT),(t+1<NT),(t+1<NT));       ENDW(t);   RESC(); ROT();
    STEP(pA0,pA1,pB0,pB1,t+1,(t+4<NT),(t+2<NT),(t+2<NT));     ENDW(t+1); RESC(); ROT();
  }
  STEP(pB0,pB1,pA0,pA1,NT-1,false,false,false); RESC();
  { float sacc=pB0[0]+pB0[1]; _Pragma("unroll") for(int r=2;r<16;++r)sacc+=pB0[r]; _Pragma("unroll") for(int r=0;r<16;++r)sacc+=pB1[r]; l_reg+=sacc;
    pw0=(u32x4){PKW(pB0,0),PKW(pB0,2),PKW(pB0,4),PKW(pB0,6)};pw1=(u32x4){PKW(pB0,8),PKW(pB0,10),PKW(pB0,12),PKW(pB0,14)};pw2=(u32x4){PKW(pB1,0),PKW(pB1,2),PKW(pB1,4),PKW(pB1,6)};pw3=(u32x4){PKW(pB1,8),PKW(pB1,10),PKW(pB1,12),PKW(pB1,14)};
    SBAR(); pv(o,vb0+sl_cur,PAF(0),PAF(1),PAF(2),PAF(3)); }
  #undef PKW
  #undef PAF
  #undef VFR
  #undef PIN
  #undef MX3
  #undef GAPA
  #undef GAPB
  #undef EX
  #undef VRD
  #undef KRD
  #undef STEP
  #undef ENDW
  {auto rr=__builtin_amdgcn_permlane32_swap(__float_as_uint(l_reg),__float_as_uint(l_reg),false,false);l_reg=__uint_as_float(rr[0])+__uint_as_float(rr[1]);}
  if(hi==0)wsf[32+r32]=l_reg;asm volatile("s_waitcnt lgkmcnt(0)":::"memory");
  float rli[16];
  #pragma unroll
  for(int r=0;r<16;++r)rli[r]=__builtin_amdgcn_rcpf(wsf[32+crow(r,hi)]);
  bf16*Ow=O+(rowbase+q0+wid*QBLK)*DM+h*D;
  { bf16*stg=(bf16*)(shm+LDS_OST)+wid*2048;
    #pragma unroll
    for(int r=0;r<16;++r){const int orow=crow(r,hi);
      #pragma unroll
      for(int d0=0;d0<2;++d0)stg[orow*64+d0*32+r32]=__float2bfloat16(o[d0][r]*rli[r]);}
    asm volatile("s_waitcnt lgkmcnt(0)":::"memory");
    #pragma unroll
    for(int i=0;i<4;++i){const int row=i*8+(lane>>3),ch=lane&7; const u32x4 v=*(const u32x4*)(stg+row*64+ch*8); ATTN_STORE16(Ow+(long)row*DM+ch*8,v);} }
  asm volatile("s_waitcnt lgkmcnt(0)\n\ts_barrier":::"memory");
  #undef DMA_K
  #undef DMA_V
  #undef KAUG
  #undef QAUG
  #undef SETM
  #undef CMASK
  #undef START
  #undef RESC
  #undef ROT
}
constexpr int ATTN_LDS_BYTES=LDS_BYTES;
struct AttnTensors { const bf16* Q; const bf16* K; const bf16* V; bf16* O; const float* CUM; };
struct AttnUnit { int bh; int qb; };
struct StaticOrder {
  int vcu;
  __device__ __forceinline__ explicit StaticOrder(int grid,int block):vcu((block%8)*(grid/8)+block/8){}
  __device__ __forceinline__ bool next(int i,AttnUnit&u)const{ if(i>=2)return false; const int s=vcu&15; u.bh=vcu>>4; u.qb=(i==0)?s:31-s; return true; }
  __device__ __forceinline__ void a_ready(const AttnUnit&)const{}
  __device__ __forceinline__ void done(const AttnUnit&)const{}
};
template<class Sched,int THRL=8> __device__ __forceinline__ void attn_phase(char*lds,const AttnTensors&T,const Sched&S){
  AttnUnit u;
  for(int i=0;S.next(i,u);++i){ S.a_ready(u); attn_unit<THRL>(u.bh/NHEAD,u.bh%NHEAD,u.qb,T.Q,T.K,T.V,T.O,T.CUM,lds); S.done(u); }
}
#undef SBAR
#undef WAIT_BAR
}
namespace mk {
namespace cgx = cooperative_groups;

#define GSYNC() do { __builtin_amdgcn_fence(__ATOMIC_RELEASE, "agent"); grid.sync(); __builtin_amdgcn_fence(__ATOMIC_ACQUIRE, "agent"); } while (0)

#define PHASE_IDS() int tid_ = threadIdx.x; asm volatile("" : "+v"(tid_)); const int lane_ = tid_ & 63, wave_ = __builtin_amdgcn_readfirstlane(tid_ >> 6); \
    int bx_ = blockIdx.x; asm volatile("" : "+s"(bx_)); const int gw_ = bx_ * NWAVES + wave_, gt_ = bx_ * NTHR + tid_; unsigned char* ws_ = launder(a.ws); \
    (void)lane_; (void)gw_; (void)gt_; (void)ws_
__global__ void __launch_bounds__(NTHR, 2) mega_fwd(Args a) {
    extern __shared__ __attribute__((aligned(16))) unsigned char lds_raw[];
    cgx::grid_group grid = cgx::this_grid();
    LAS unsigned char* lds = (LAS unsigned char*)lds_raw;
    const int Gn = gridDim.x;
    const int NGW = Gn * NWAVES, NGT = Gn * NTHR;
    float* X = a.out;

    {
        PHASE_IDS(); LAS float* scr = (LAS float*)(lds + wave_ * 16384);
        for (int it = gw_; it < MODP_ITEMS + CV_TOTAL; it += NGW) { if (it < MODP_ITEMS) modp_item(a, it, lane_); else conv_item(a, 0, it - MODP_ITEMS, scr, lane_); }
        if (gt_ < 2 * 32 * 64) ssm_tables(a, gt_);
    }
    GSYNC();
    {
        PHASE_IDS();
        for (int i = gt_; i < 2 * 32 * 16 * 32 * 16; i += NGT) kt_entry(a, i);
        for (int i = gt_; i < 6 * 2 * 1024; i += NGT) coef_entry(a, i);
    }
    GSYNC();
    {
        PHASE_IDS(); const float* COEF = (const float*)(ws_ + WS_COEF); bf16_t* XN = (bf16_t*)(ws_ + WS_XN);
        for (int m = gw_; m < M; m += NGW) prenorm_row(a.in[I_X] + (size_t)m * D, COEF + ((size_t)(0 * 2 + m / L) * 3 + 1) * D, XN + (size_t)m * D, lane_);
        for (int it = gw_; it < SSM_MAT_ITEMS; it += NGW) ssm_mat_item(a, 0, it, lane_);
    }
    GSYNC();

    int sdone = 0;
    for (int l = 0; l < DEPTH; ++l) {
        if (l > 0) {
            PHASE_IDS(); LAS float* scr = (LAS float*)(lds + wave_ * 16384);
            for (int it = gw_; it < CV_TOTAL + SSM_MAT_ITEMS; it += NGW) { if (it < CV_TOTAL) conv_item(a, l, it, scr, lane_); else ssm_mat_item(a, l, it - CV_TOTAL, lane_); }
            GSYNC();
        }
        for (int sub = 0; sub < 3; ++sub) {
            if (sdone >= a.n_sub) return;
            const int s = l * 3 + sub;
            const float* xin = (s == 0) ? a.in[I_X] : X;
            if (sub != 1) {
                const int f = sub == 0 ? 0 : 1;
                {
                    PHASE_IDS();
                    pg8::Gemm g{(const bf16_t*)(ws_ + WS_XN), (const bf16_t*)(ws_ + WS_WFI) + (size_t)f * 2 * FF * D, M, 2 * FF, D, D, D};
                    pg8::StaticOrder S; S.init(M, 2 * FF, Gn, bx_);
                    EpiSwiglu E{(bf16_t*)(ws_ + WS_AFFN), FF};
                    pg8::gemm_phase<EpiSwiglu, pg8::StaticOrder, true, true>(lds, g, S, E);
                }
                GSYNC();
                {
                    PHASE_IDS();
                    pg8::Gemm g{(const bf16_t*)(ws_ + WS_AFFN), (const bf16_t*)(ws_ + WS_WFO) + (size_t)f * D * FF, M, D, FF, FF, FF};
                    pg8::StaticOrder S; S.init(M, D, Gn, bx_);
                    EpiF32 E{(float*)(ws_ + WS_Y), D};
                    pg8::gemm_phase<EpiF32, pg8::StaticOrder, true, true>(lds, g, S, E);
                }
                GSYNC();
            } else {
                {
                    PHASE_IDS();
                    pg8::Gemm g{(const bf16_t*)(ws_ + WS_XN), (const bf16_t*)(ws_ + WS_WMI), M, INWP, D, D, D};
                    pg8::StaticOrder S; S.init(M, INWP, Gn, bx_);
                    EpiInProj E{(bf16_t*)(ws_ + WS_UG), (bf16_t*)(ws_ + WS_Q), (bf16_t*)(ws_ + WS_SGA), (float*)(ws_ + WS_LF), a.in[I_FB] + l * H};
                    pg8::gemm_phase<EpiInProj, pg8::StaticOrder, true, true>(lds, g, S, E);
                }
                GSYNC();
                {
                    PHASE_IDS();
                    if (bx_ < 16) cum_block((const float*)(ws_ + WS_LF), (float*)(ws_ + WS_CUM), bx_, (LAS float*)lds, tid_);
                    pg8::Gemm g{(const bf16_t*)(ws_ + WS_UG), (const bf16_t*)(ws_ + WS_BTF), 32 * 512, 32 * 256, 512, UGK, 512};
                    LocalOrder S{bx_ - 16}; EpiLocal E{(float*)(ws_ + WS_LOCAL)};
                    pg8::gemm_phase<EpiLocal, LocalOrder, false, true>(lds, g, S, E);
                }
                GSYNC();
                {
                    PHASE_IDS();
                    if (gt_ < 2 * 32 * 64) carry_scan(a, l, gt_);
                }
                GSYNC();
                {
                    PHASE_IDS();
                    const attn_body::AttnTensors AT{(const attn_body::bf16*)(ws_ + WS_Q), (const attn_body::bf16*)(ws_ + WS_K), (const attn_body::bf16*)(ws_ + WS_V), (attn_body::bf16*)(ws_ + WS_Q), (const float*)(ws_ + WS_CUM)};
                    const attn_body::StaticOrder SA(Gn, bx_);
                    attn_body::attn_phase<attn_body::StaticOrder>((char*)lds_raw, AT, SA);
                }
                {
                    PHASE_IDS();
                    pg8::Gemm g{(const bf16_t*)(ws_ + WS_UG), (const bf16_t*)(ws_ + WS_BTY), 32 * 512, 32 * 512, UGK, UGK, UGK};
                    SsmYOrder S{bx_}; EpiSsmY E{(const bf16_t*)(ws_ + WS_UG), (bf16_t*)(ws_ + WS_YS), a.in[I_SD] + l * 512};
                    pg8::gemm_phase<EpiSsmY, SsmYOrder, false, true>(lds, g, S, E);
                }
                GSYNC();
                {
                    PHASE_IDS();
                    pg8::Gemm g{(const bf16_t*)(ws_ + WS_Q), (const bf16_t*)(ws_ + WS_WAO), M, D, 512, 512, 512};
                    pg8::StaticOrder S; S.init(M, D, Gn, bx_);
                    EpiAO E{(const bf16_t*)(ws_ + WS_SGB), (bf16_t*)(ws_ + WS_YBG)};
                    pg8::gemm_phase<EpiAO, pg8::StaticOrder, true, true>(lds, g, S, E);
                }
                GSYNC();
                {
                    PHASE_IDS();
                    pg8::Gemm g{(const bf16_t*)(ws_ + WS_YS), (const bf16_t*)(ws_ + WS_WGLU), M, 2 * D, 512, 512, 512};
                    pg8::StaticOrder S; S.init(M, 2 * D, Gn, bx_);
                    EpiGLU E{(const bf16_t*)(ws_ + WS_SGA), (const bf16_t*)(ws_ + WS_YBG), (bf16_t*)(ws_ + WS_MERGED)};
                    pg8::gemm_phase<EpiGLU, pg8::StaticOrder, true, true>(lds, g, S, E);
                }
                GSYNC();
                {
                    PHASE_IDS();
                    pg8::Gemm g{(const bf16_t*)(ws_ + WS_MERGED), (const bf16_t*)(ws_ + WS_WMO), M, D, D, D, D};
                    pg8::StaticOrder S; S.init(M, D, Gn, bx_);
                    EpiF32 E{(float*)(ws_ + WS_Y), D};
                    pg8::gemm_phase<EpiF32, pg8::StaticOrder, true, true>(lds, g, S, E);
                }
                GSYNC();
            }
            {
                PHASE_IDS(); const float* COEF = (const float*)(ws_ + WS_COEF); bf16_t* XN = (bf16_t*)(ws_ + WS_XN); const float* Y = (const float*)(ws_ + WS_Y);
                const bool last = (s == 5);
                for (int m = gw_; m < M; m += NGW) { const int b = m / L;
                    postnorm_row(xin + (size_t)m * D, X + (size_t)m * D, Y + (size_t)m * D, COEF + ((size_t)(s * 2 + b) * 3 + 0) * D,
                                 last ? nullptr : COEF + ((size_t)((s + 1) * 2 + b) * 3 + 1) * D, last ? nullptr : XN + (size_t)m * D, lane_); }
            }
            GSYNC();
            ++sdone;
        }
    }
}

static int g_grid = 0;
static bool launch(const Args& a, hipStream_t stream) {
    if (g_grid == 0) {
        int dev = 0, cus = 0, per_cu = 0;
        if (hipGetDevice(&dev) != hipSuccess || hipDeviceGetAttribute(&cus, hipDeviceAttributeMultiprocessorCount, dev) != hipSuccess) { fprintf(stderr, "mk: device query failed\n"); g_grid = -1; return false; }
        if (hipFuncSetAttribute((const void*)mega_fwd, hipFuncAttributeMaxDynamicSharedMemorySize, LDS_BYTES) != hipSuccess) { fprintf(stderr, "mk: hipFuncSetAttribute failed\n"); g_grid = -1; return false; }
        if (hipOccupancyMaxActiveBlocksPerMultiprocessor(&per_cu, (const void*)mega_fwd, NTHR, LDS_BYTES) != hipSuccess || per_cu < 1) { fprintf(stderr, "mk: occupancy query says %d\n", per_cu); g_grid = -1; return false; }
        (void)hipGetLastError();
        g_grid = cus;
        fprintf(stderr, "mk: grid %d (per_cu %d)\n", g_grid, per_cu);
    }
    if (g_grid < 0) return false;
    Args al = a;
    void* params[] = {(void*)&al};
    const hipError_t e = hipLaunchCooperativeKernel((const void*)mega_fwd, dim3(g_grid), dim3(NTHR), params, LDS_BYTES, stream);
    if (e != hipSuccess) { fprintf(stderr, "mk: cooperative launch failed: %s\n", hipGetErrorString(e)); return false; }
    return true;
}
}
extern "C" void kernel_launch(void* const* d_in, const int* in_sizes, int n_in, void* d_out, int out_size, void* d_ws, size_t ws_size, hipStream_t stream) {
    if (n_in != 21 || ws_size < mk::WS_END || out_size != mk::M * mk::D) { fprintf(stderr, "kernel_launch: bad n_in %d, out %d or ws %zu\n", n_in, out_size, ws_size); return; }
    mk::Args a{};
    for (int i = 0; i < 21; ++i) a.in[i] = (const float*)d_in[i];
    a.out = (float*)d_out; a.ws = (unsigned char*)d_ws; a.n_sub = 6;
    (void)mk::launch(a, stream);
}
```

```cpp
#include <hip/hip_runtime.h>
#include <hip/hip_cooperative_groups.h>
#include <cstdio>
#include <cstdint>
#include <cmath>
namespace pg8 {
#define PG8_LAS __attribute__((address_space(3)))
typedef unsigned short bf16_t;
typedef short bf16x8 __attribute__((ext_vector_type(8)));
typedef float f32x4 __attribute__((ext_vector_type(4)));
typedef unsigned u32x4 __attribute__((ext_vector_type(4)));
constexpr int BM = 256, BK = 64, HALF = 128, HTB = HALF * BK * 2  , STAGE_BYTES = 8 * HTB, NXCD = 8, WGM = 8;

__host__ __device__ __forceinline__ int lds_byte(int r, int c) { const int st = (r >> 4) * 2 + (c >> 5), rr = r & 15, cc = c & 31, ob = rr * 64 + cc * 2; return st * 1024 + (ob ^ (((ob >> 9) & 1) << 5)); }
__host__ __device__ __forceinline__ void stage_rc(int b, int& R, int& C) { const int st = b / 1024, sb = b % 1024, swz = sb ^ (((sb >> 9) & 1) << 5); R = (st >> 1) * 16 + swz / 64; C = (st & 1) * 32 + (swz % 64) / 2; }
__host__ __device__ __forceinline__ int perm32(int rho) { const int n = rho >> 4, i = rho & 15; return 8 * (i >> 2) + 4 * n + (i & 3); }

struct Unit { int pm, pn; };
struct Gemm { const bf16_t* A; const bf16_t* Bt; int M, N, K, lda, ldb; };

struct StaticOrder {
    int nM, nN, nwg, G, c;
    __host__ __device__ void init(int M, int N, int G_, int c_) { nM = M / BM; nN = N / BM; nwg = nM * nN; G = G_; c = c_; }
    __host__ __device__ bool next(int i, Unit& u) const {
        const long L = (long)i * G + c; if (L >= nwg) return false;
        int wgid = (int)L; { const int q = nwg / NXCD, r = nwg % NXCD, xcd = wgid % NXCD, off = wgid / NXCD; wgid = (xcd < r ? xcd * (q + 1) : r * (q + 1) + (xcd - r) * q) + off; }
        const int nig = WGM * nN, gid = wgid / nig, fm = gid * WGM, gsz = (nM - fm) < WGM ? (nM - fm) : WGM;
        u.pm = fm + ((wgid % nig) % gsz); u.pn = (wgid % nig) / gsz; return true;
    }
    __device__ __forceinline__ void a_ready(const Unit&) const {}
    __device__ __forceinline__ void done(const Unit&) const {}
};

__device__ __forceinline__ unsigned cvt_pk_bf16(float lo, float hi) { unsigned r; asm volatile("v_cvt_pk_bf16_f32 %0, %1, %2" : "=v"(r) : "v"(lo), "v"(hi)); return r; }
typedef float f32x2 __attribute__((ext_vector_type(2)));
__device__ __forceinline__ f32x2 gelu_pk(f32x2 v) {
    const f32x2 av = __builtin_elementwise_abs(v), d = av * 0.2316418882f + 1.0f;
    f32x2 t; t.x = __builtin_amdgcn_rcpf(d.x); t.y = __builtin_amdgcn_rcpf(d.y);
    f32x2 q = t * 0.5307027145f + (-0.7265760135f); q = q * t + 0.7107068705f; q = q * t + (-0.142248368f); q = q * t + 0.127414796f; q = q * t;
    const f32x2 s = (v * v) * (-0.72134752044f);
    f32x2 e; e.x = __builtin_amdgcn_exp2f(s.x); e.y = __builtin_amdgcn_exp2f(s.y);
    const f32x2 m = v * (q * e), r = v - m;
    f32x2 o; o.x = v.x < 0.f ? m.x : r.x; o.y = v.y < 0.f ? m.y : r.y; return o;
}
template <class Epi, class Sched, bool ALIGN_EPI = false, bool SP2 = false>
__device__ __forceinline__ void gemm_phase(PG8_LAS unsigned char* lds, const Gemm g, const Sched& S, const Epi& E) {
    int tid_ = threadIdx.x; asm volatile("" : "+v"(tid_));
    const int tid = tid_, wid = __builtin_amdgcn_readfirstlane(tid >> 6), lane = tid & 63, wr = wid >> 2, wc = wid & 3, fr = lane & 15, fq = lane >> 4;
    const int K = g.K, nt = K / BK;
    unsigned voffA[2], voffB[2];
#pragma unroll
    for (int i = 0; i < 2; ++i) { int R, C; stage_rc(tid * 16 + i * 8192, R, C); const int Rb = Epi::PERM ? ((R & ~31) + perm32(R & 31)) : R;
        voffA[i] = (unsigned)(R * g.lda + C) * 2u; voffB[i] = (unsigned)(Rb * g.ldb + C) * 2u; }
    const size_t kstep = (size_t)(BK * 2);
    const size_t hstepA = (size_t)HALF * g.lda * 2, hstepB = (size_t)HALF * g.ldb * 2;
    const size_t tstepA = 2 * hstepA, tstepB = 2 * hstepB;
    const unsigned ldsw = (unsigned)wid * 1024u;
    const int aoff = lds_byte(wr * 64 + fr, fq * 8), boff = lds_byte(wc * 32 + fr, fq * 8);
#define PG8_SA(b, h) (((b) * 2 + (h)) * HTB)
#define PG8_SB(b, h) ((4 + (b) * 2 + (h)) * HTB)
#define PG8_STAGE(bufoff, gbase, voff) do { _Pragma("unroll") for (int _i = 0; _i < 2; ++_i) \
        __builtin_amdgcn_global_load_lds((const unsigned*)((const char*)(gbase) + (voff)[_i]), (PG8_LAS unsigned*)(lds + (bufoff) + ldsw + _i * 8192), 16, 0, 0); } while (0)
#define PG8_LDA(dst, b, h) do { _Pragma("unroll") for (int m = 0; m < 4; ++m) _Pragma("unroll") for (int k = 0; k < 2; ++k) dst[m][k] = *(const PG8_LAS bf16x8*)(lds + PG8_SA(b, h) + aoff + m * 2048 + k * 1024); } while (0)
#define PG8_LDB(dst, b, h) do { _Pragma("unroll") for (int n = 0; n < 2; ++n) _Pragma("unroll") for (int k = 0; k < 2; ++k) dst[n][k] = *(const PG8_LAS bf16x8*)(lds + PG8_SB(b, h) + boff + n * 2048 + k * 1024); } while (0)
#define PG8_MMA(ai, bj, At, Bt) do { __builtin_amdgcn_s_setprio(1); _Pragma("unroll") for (int m = 0; m < 4; ++m) _Pragma("unroll") for (int n = 0; n < 2; ++n) _Pragma("unroll") for (int k = 0; k < 2; ++k) \
        acc[ai][bj][m][n] = __builtin_amdgcn_mfma_f32_16x16x32_bf16(Bt[n][k], At[m][k], acc[ai][bj][m][n], 0, 0, 0); __builtin_amdgcn_s_setprio(0); } while (0)
#define PG8_WAIT_V(n) asm volatile("s_waitcnt vmcnt(" #n ")" ::: "memory")
#define PG8_WAIT_L(n) asm volatile("s_waitcnt lgkmcnt(" #n ")" ::: "memory")
#define PG8_BAR __builtin_amdgcn_s_barrier()
#define PG8_SCHED __builtin_amdgcn_sched_barrier(0)
    Unit cur, nxt; int ui = 0;
    if (!S.next(0, cur)) return;
    f32x4 acc[2][2][4][2];
#pragma unroll
    for (int a = 0; a < 2; ++a)
#pragma unroll
        for (int b = 0; b < 2; ++b)
#pragma unroll
            for (int m = 0; m < 4; ++m)
#pragma unroll
                for (int n = 0; n < 2; ++n) acc[a][b][m][n] = (f32x4){0.f, 0.f, 0.f, 0.f};
    bf16x8 At[4][2], B0[2][2], B1[2][2];
    const char* cA = (const char*)g.A + (size_t)cur.pm * tstepA; const char* cB = (const char*)g.Bt + (size_t)cur.pn * tstepB;
    S.a_ready(cur);
    if constexpr (SP2) {
        PG8_STAGE(PG8_SB(0, 0), cB, voffB); PG8_STAGE(PG8_SB(0, 1), cB + hstepB, voffB); PG8_STAGE(PG8_SA(0, 0), cA, voffA); PG8_STAGE(PG8_SA(0, 1), cA + hstepA, voffA);
        if (wr == 1) PG8_BAR;
        PG8_WAIT_V(2); PG8_BAR;
        PG8_STAGE(PG8_SB(1, 0), cB + kstep, voffB); PG8_STAGE(PG8_SA(1, 0), cA + kstep, voffA); PG8_STAGE(PG8_SB(1, 1), cB + hstepB + kstep, voffB);
        PG8_WAIT_V(6); PG8_BAR;
    } else {
        PG8_STAGE(PG8_SB(0, 0), cB, voffB); PG8_STAGE(PG8_SA(0, 0), cA, voffA); PG8_STAGE(PG8_SB(0, 1), cB + hstepB, voffB); PG8_STAGE(PG8_SA(0, 1), cA + hstepA, voffA);
        if (wr == 1) PG8_BAR;
        PG8_WAIT_V(4); PG8_BAR;
        PG8_STAGE(PG8_SB(1, 0), cB + kstep, voffB); PG8_STAGE(PG8_SA(1, 0), cA + kstep, voffA); PG8_STAGE(PG8_SB(1, 1), cB + hstepB + kstep, voffB);
        PG8_WAIT_V(6); PG8_BAR;
    }
    for (;;) {
        const bool has_next = S.next(ui + 1, nxt);
        const char* nA = has_next ? (const char*)g.A + (size_t)nxt.pm * tstepA : cA; const char* nB = has_next ? (const char*)g.Bt + (size_t)nxt.pn * tstepB : cB;
        for (int t = 0; t < nt; t += 2) {
            const bool last = (t == nt - 2);
            const char* a1 = cA + (size_t)(t + 1) * kstep;
            const char* a2 = last ? nA : cA + (size_t)(t + 2) * kstep; const char* b2 = last ? nB : cB + (size_t)(t + 2) * kstep;
            const char* a3 = a2 + kstep; const char* b3 = b2 + kstep;
            if (last && has_next) S.a_ready(nxt);
            if constexpr (SP2) {
            PG8_LDB(B0, 0, 0); PG8_LDB(B1, 0, 1); PG8_SCHED; PG8_LDA(At, 0, 0); PG8_STAGE(PG8_SA(1, 1), a1 + hstepA, voffA);
            PG8_WAIT_V(8); PG8_WAIT_L(0); PG8_BAR; PG8_MMA(0, 0, At, B0); PG8_MMA(0, 1, At, B1); PG8_BAR; PG8_SCHED;
            PG8_LDA(At, 0, 1); PG8_STAGE(PG8_SB(0, 0), b2, voffB); PG8_STAGE(PG8_SB(0, 1), b2 + hstepB, voffB); PG8_STAGE(PG8_SA(0, 0), a2, voffA);
            PG8_WAIT_V(8); PG8_WAIT_L(0); PG8_BAR; PG8_MMA(1, 0, At, B0); PG8_MMA(1, 1, At, B1); PG8_BAR; PG8_SCHED;
            PG8_LDB(B0, 1, 0); PG8_LDB(B1, 1, 1); PG8_SCHED; PG8_LDA(At, 1, 0); PG8_STAGE(PG8_SA(0, 1), a2 + hstepA, voffA);
            PG8_WAIT_V(8); PG8_WAIT_L(0); PG8_BAR; PG8_MMA(0, 0, At, B0); PG8_MMA(0, 1, At, B1); PG8_BAR; PG8_SCHED;
            PG8_LDA(At, 1, 1); PG8_STAGE(PG8_SB(1, 0), b3, voffB); PG8_STAGE(PG8_SB(1, 1), b3 + hstepB, voffB); PG8_STAGE(PG8_SA(1, 0), a3, voffA);
            PG8_WAIT_V(8); PG8_WAIT_L(0); PG8_BAR; PG8_MMA(1, 0, At, B0); PG8_MMA(1, 1, At, B1); PG8_BAR; PG8_SCHED;
            } else {
            PG8_LDB(B0, 0, 0); PG8_SCHED; PG8_LDA(At, 0, 0); PG8_STAGE(PG8_SA(1, 1), a1 + hstepA, voffA);
            PG8_WAIT_L(8); PG8_BAR; PG8_WAIT_L(0); PG8_MMA(0, 0, At, B0); PG8_BAR; PG8_SCHED;
            PG8_LDB(B1, 0, 1); PG8_STAGE(PG8_SB(0, 0), b2, voffB);
            PG8_BAR; PG8_WAIT_L(0); PG8_MMA(0, 1, At, B1); PG8_BAR;
            PG8_LDA(At, 0, 1); PG8_STAGE(PG8_SA(0, 0), a2, voffA);
            PG8_BAR; PG8_WAIT_L(0); PG8_MMA(1, 0, At, B0); PG8_BAR; PG8_SCHED;
            PG8_STAGE(PG8_SB(0, 1), b2 + hstepB, voffB);
            PG8_WAIT_V(6); PG8_BAR; PG8_MMA(1, 1, At, B1); PG8_BAR;
            PG8_LDB(B0, 1, 0); PG8_SCHED; PG8_LDA(At, 1, 0); PG8_STAGE(PG8_SA(0, 1), a2 + hstepA, voffA);
            PG8_WAIT_L(8); PG8_BAR; PG8_WAIT_L(0); PG8_MMA(0, 0, At, B0); PG8_BAR; PG8_SCHED;
            PG8_LDB(B1, 1, 1); PG8_STAGE(PG8_SB(1, 0), b3, voffB);
            PG8_BAR; PG8_WAIT_L(0); PG8_MMA(0, 1, At, B1); PG8_BAR;
            PG8_LDA(At, 1, 1); PG8_STAGE(PG8_SA(1, 0), a3, voffA);
            PG8_BAR; PG8_WAIT_L(0); PG8_MMA(1, 0, At, B0); PG8_BAR; PG8_SCHED;
            PG8_STAGE(PG8_SB(1, 1), b3 + hstepB, voffB);
            PG8_WAIT_V(6); PG8_BAR; PG8_MMA(1, 1, At, B1); PG8_BAR;
            }
        }
        if constexpr (ALIGN_EPI) { if (wr == 0) PG8_BAR; }
        if constexpr (!Epi::AFTER_DRAIN) { E(acc, cur, wr, wc, fr, fq); S.done(cur); }
        if (!has_next) break;
#pragma unroll
        for (int a = 0; a < 2; ++a)
#pragma unroll
            for (int b = 0; b < 2; ++b)
#pragma unroll
                for (int m = 0; m < 4; ++m)
#pragma unroll
                    for (int n = 0; n < 2; ++n) acc[a][b][m][n] = (f32x4){0.f, 0.f, 0.f, 0.f};
        cur = nxt; cA = nA; cB = nB; ++ui;
        if constexpr (ALIGN_EPI) { if (wr == 1) PG8_BAR; }
    }
    PG8_WAIT_V(0);
    if constexpr (!ALIGN_EPI) { if (wr == 0) PG8_BAR; }
    PG8_BAR;
    if constexpr (Epi::AFTER_DRAIN) { E.fused(acc, cur, wr, wc, fr, fq, lds, wid, lane); S.done(cur); }
#undef PG8_SA
#undef PG8_SB
#undef PG8_STAGE
#undef PG8_LDA
#undef PG8_LDB
#undef PG8_MMA
#undef PG8_WAIT_V
#undef PG8_WAIT_L
#undef PG8_BAR
#undef PG8_SCHED
}
}
namespace mk {
using pg8::bf16_t; using pg8::f32x4; using pg8::u32x4; using pg8::Unit;
#define LAS __attribute__((address_space(3)))
constexpr int D = 1024, NB = 2, L = 8192, M = NB * L, DEPTH = 2, FF = 2816, INW = 4104, INWP = 4352, H = 8, G = 32, P = 64, NG = 16, MODW = 9216;
constexpr int TC = 32, NCH = M / TC, UGK = 640;
constexpr int NWAVES = 8, NTHR = 512;
constexpr float LOG2E = 1.4426950408889634f;
constexpr float QSCALE = 0.125f * LOG2E;
constexpr size_t MiB = 1u << 20;
constexpr size_t WS_CTL = 0;
constexpr size_t WS_COEF = 1 * MiB;
constexpr size_t WS_MODP = 2 * MiB;
constexpr size_t WS_PW = 7 * MiB;
constexpr size_t WS_BB = WS_PW + (size_t)2 * 32 * 64 * 33 * 8;
constexpr size_t WS_KT = 9 * MiB;
constexpr size_t WS_WFI = 12 * MiB;
constexpr size_t WS_WFO = 34 * MiB;
constexpr size_t WS_WMI = 45 * MiB;
constexpr size_t WS_WGLU = 54 * MiB;
constexpr size_t WS_WAO = 56 * MiB;
constexpr size_t WS_WMO = 57 * MiB;
constexpr size_t WS_BTY = 59 * MiB;
constexpr size_t WS_BTF = 79 * MiB;
constexpr size_t WS_XN = 87 * MiB;
constexpr size_t WS_Y = 119 * MiB;
constexpr size_t WS_BIG = 183 * MiB;
constexpr size_t WS_AFFN = WS_BIG;
constexpr size_t WS_SGA = 183 * MiB, WS_SGB = 215 * MiB, WS_Q = 247 * MiB, WS_K = 263 * MiB, WS_V = 279 * MiB, WS_UG = 295 * MiB, WS_MERGED = 315 * MiB;
constexpr size_t WS_YS = 119 * MiB, WS_YBG = 135 * MiB, WS_LOCAL = 167 * MiB, WS_LF = 175 * MiB, WS_CUM = 176 * MiB;
constexpr size_t WS_END = 347 * MiB;
constexpr int RING_BYTES = 131072, LDS_BYTES = 147456;

typedef float f32x2 __attribute__((ext_vector_type(2)));
typedef unsigned u32x2 __attribute__((ext_vector_type(2)));
#define LDS_WAIT() asm volatile("s_waitcnt lgkmcnt(0)" ::: "memory")
__device__ __forceinline__ unsigned cvt_pk(float lo, float hi) { unsigned r; asm volatile("v_cvt_pk_bf16_f32 %0, %1, %2" : "=v"(r) : "v"(lo), "v"(hi)); return r; }
__device__ __forceinline__ float bf_lo(unsigned w) { return __uint_as_float(w << 16); }
__device__ __forceinline__ float bf_hi(unsigned w) { return __uint_as_float(w & 0xffff0000u); }
__device__ __forceinline__ float fast_sigmoid(float v) { return __builtin_amdgcn_rcpf(1.f + __builtin_amdgcn_exp2f(-LOG2E * v)); }
__device__ __forceinline__ float fast_silu(float v) { return v * fast_sigmoid(v); }
__device__ __forceinline__ float fast_gelu_tanh(float v) {
    const float z2 = 1.5957691216057308f * (v + 0.044715f * v * v * v); return v * fast_sigmoid(z2); }
__device__ __forceinline__ float wave_sum(float v) {
#pragma unroll
    for (int o = 1; o < 64; o <<= 1) v += __shfl_xor(v, o);
    return v;
}

template <class T> __device__ __forceinline__ T* launder(T* p) { asm volatile("" : "+s"(p)); return p; }
struct Args { const float* in[21]; float* out; unsigned char* ws; int n_sub; int pad; };
enum { I_X = 0, I_C, I_MODW, I_MODB, I_NPRE, I_NPOST, I_FWIN, I_FWOUT, I_MWIN, I_FB, I_ARE, I_AIM, I_LDT, I_BRE, I_BIM, I_CRE, I_CIM, I_SD, I_GLU, I_AO, I_MO };

struct EpiSwiglu {
    static constexpr bool PERM = true, AFTER_DRAIN = false;
    bf16_t* O; int ldc;
    __device__ __forceinline__ void operator()(const f32x4 (&acc)[2][2][4][2], const Unit& u, int wr, int wc, int fr, int fq) const {
        const int row0 = u.pm * 256 + wr * 64 + fr, col0 = u.pn * 128 + wc * 32 + 8 * fq;
#pragma unroll
        for (int ai = 0; ai < 2; ++ai)
#pragma unroll
            for (int m = 0; m < 4; ++m) {
                bf16_t* rowp = O + (size_t)(row0 + ai * 128 + m * 16) * ldc + col0;
                const f32x4 g0 = acc[ai][0][m][0], g1 = acc[ai][0][m][1], u0 = acc[ai][1][m][0], u1 = acc[ai][1][m][1];
                u32x4 w;
                w.x = cvt_pk(fast_silu(g0[0]) * u0[0], fast_silu(g0[1]) * u0[1]); w.y = cvt_pk(fast_silu(g0[2]) * u0[2], fast_silu(g0[3]) * u0[3]);
                w.z = cvt_pk(fast_silu(g1[0]) * u1[0], fast_silu(g1[1]) * u1[1]); w.w = cvt_pk(fast_silu(g1[2]) * u1[2], fast_silu(g1[3]) * u1[3]);
                *(u32x4*)rowp = w;
            }
    }
};
struct EpiF32 {
    static constexpr bool PERM = false, AFTER_DRAIN = false;
    float* C; int ldc;
    __device__ __forceinline__ void operator()(const f32x4 (&acc)[2][2][4][2], const Unit& u, int wr, int wc, int fr, int fq) const {
        const int row0 = u.pm * 256 + wr * 64 + fr, col0 = u.pn * 256 + wc * 32 + 4 * fq;
#pragma unroll
        for (int ai = 0; ai < 2; ++ai)
#pragma unroll
            for (int m = 0; m < 4; ++m) { float* rowp = C + (size_t)(row0 + ai * 128 + m * 16) * ldc + col0;
#pragma unroll
                for (int bj = 0; bj < 2; ++bj)
#pragma unroll
                    for (int n = 0; n < 2; ++n) *(f32x4*)(rowp + bj * 128 + n * 16) = acc[ai][bj][m][n]; }
    }
};

__device__ __forceinline__ void transpose_item(const float* __restrict__ W, int ldw, bf16_t* __restrict__ WT, int ldt, int k0, int src_col0, int dst_row0, int nvalid, LAS float* scr, int lane) {
    const int c0 = lane & 31;
#pragma unroll 8
    for (int i = 0; i < 32; ++i) { const int kk = 2 * i + (lane >> 5); scr[kk * 33 + c0] = (c0 < nvalid) ? W[(size_t)(k0 + kk) * ldw + src_col0 + c0] : 0.f; }
    LDS_WAIT(); asm volatile("" ::: "memory");
    const int c = lane & 7;
#pragma unroll
    for (int j = 0; j < 4; ++j) { const int n = (lane >> 3) + 8 * j; const LAS float* s = scr + (8 * c) * 33 + n;
        u32x4 o; o.x = cvt_pk(s[0 * 33], s[1 * 33]); o.y = cvt_pk(s[2 * 33], s[3 * 33]); o.z = cvt_pk(s[4 * 33], s[5 * 33]); o.w = cvt_pk(s[6 * 33], s[7 * 33]);
        *(u32x4*)(WT + (size_t)(dst_row0 + n) * ldt + k0 + 8 * c) = o; }
    LDS_WAIT(); asm volatile("" ::: "memory");
}
constexpr int CV_FI = 2 * 16 * 176, CV_FO = 2 * 44 * 32, CV_MI = 16 * 136, CV_GLU = 8 * 64, CV_AO = 8 * 32, CV_MO = 16 * 32, CV_TOTAL = CV_FI + CV_FO + CV_MI + CV_GLU + CV_AO + CV_MO;
__device__ __forceinline__ void conv_item(const Args& a, int l, int it, LAS float* scr, int lane) {
    unsigned char* ws = a.ws;
    if (it < CV_FI) { const int f = it / (16 * 176), r = it % (16 * 176), kb = r / 176, nb = r % 176, n0 = nb * 32, pn = n0 >> 8, w = n0 & 255;
        const int src = (w < 128) ? (128 * pn + w) : (FF + 128 * pn + (w - 128));
        transpose_item(a.in[I_FWIN] + (size_t)(l * 2 + f) * D * 2 * FF, 2 * FF, (bf16_t*)(ws + WS_WFI) + (size_t)f * 2 * FF * D, D, kb * 64, src, n0, 32, scr, lane); return; }
    it -= CV_FI;
    if (it < CV_FO) { const int f = it / (44 * 32), r = it % (44 * 32), kb = r / 32, nb = r % 32;
        transpose_item(a.in[I_FWOUT] + (size_t)(l * 2 + f) * FF * D, D, (bf16_t*)(ws + WS_WFO) + (size_t)f * D * FF, FF, kb * 64, nb * 32, nb * 32, 32, scr, lane); return; }
    it -= CV_FO;
    if (it < CV_MI) { const int kb = it / 136, nb = it % 136, n0 = nb * 32; int src, nv;
        if (n0 < 2048) { src = n0; nv = 32; } else if (n0 < 4096) { src = n0 + 8; nv = 32; } else if (n0 == 4096) { src = 2048; nv = 8; } else { src = 0; nv = 0; }
        transpose_item(a.in[I_MWIN] + (size_t)l * D * INW, INW, (bf16_t*)(ws + WS_WMI), D, kb * 64, src, n0, nv, scr, lane); return; }
    it -= CV_MI;
    if (it < CV_GLU) { const int kb = it / 64, nb = it % 64, n0 = nb * 32, pn = n0 >> 8, w = n0 & 255;
        const int src = (w < 128) ? (128 * pn + w) : (D + 128 * pn + (w - 128));
        transpose_item(a.in[I_GLU] + (size_t)l * 512 * 2048, 2048, (bf16_t*)(ws + WS_WGLU), 512, kb * 64, src, n0, 32, scr, lane); return; }
    it -= CV_GLU;
    if (it < CV_AO) { const int kb = it / 32, nb = it % 32;
        transpose_item(a.in[I_AO] + (size_t)l * 512 * D, D, (bf16_t*)(ws + WS_WAO), 512, kb * 64, nb * 32, nb * 32, 32, scr, lane); return; }
    it -= CV_AO;
    { const int kb = it / 32, nb = it % 32;
        transpose_item(a.in[I_MO] + (size_t)l * D * D, D, (bf16_t*)(ws + WS_WMO), D, kb * 64, nb * 32, nb * 32, 32, scr, lane); }
}
constexpr int MODP_ITEMS = 2 * 36 * 8;
__device__ __forceinline__ void modp_item(const Args& a, int it, int lane) {
    const int l = it / 288, r = it % 288, cgp = r / 8, kc = r % 8, j0 = cgp * 256 + lane * 4;
    const float* c = a.in[I_C]; const float* w = a.in[I_MODW] + ((size_t)l * D + kc * 128) * MODW + j0;
    f32x4 a0 = {0.f, 0.f, 0.f, 0.f}, a1 = {0.f, 0.f, 0.f, 0.f};
#pragma unroll 8
    for (int k = 0; k < 128; ++k) { const f32x4 wv = *(const f32x4*)(w + (size_t)k * MODW); const float c0 = c[kc * 128 + k], c1 = c[D + kc * 128 + k];
        const float s0 = c0 / (1.f + __expf(-c0)), s1 = c1 / (1.f + __expf(-c1)); a0 += wv * s0; a1 += wv * s1; }
    float* mp = (float*)(a.ws + WS_MODP) + (size_t)kc * 2 * 2 * MODW + (size_t)l * 2 * MODW + j0;
    *(f32x4*)mp = a0; *(f32x4*)(mp + MODW) = a1;
}
__device__ __forceinline__ void ssm_tables(const Args& a, int idx) {
    const int l = idx >> 11, gp = idx & 2047, g = gp >> 6;
    const float ar = fminf(a.in[I_ARE][idx], -1e-4f), ai = a.in[I_AIM][idx], dt = expf(a.in[I_LDT][l * G + g]);
    float sn, cs; sincosf(ai * dt, &sn, &cs);
    const float ea = expf(ar * dt), lr = ea * cs, li = ea * sn;
    const float sh = sinf(0.5f * ai * dt), nr = expm1f(ar * dt) * cs - 2.0f * sh * sh, ni = li, den = ar * ar + ai * ai;
    const float fr = (nr * ar + ni * ai) / den, fi = (ni * ar - nr * ai) / den;
    f32x2* pw = (f32x2*)(a.ws + WS_PW) + (size_t)idx * 33;
    double wr = 1.0, wi = 0.0; const double lrd = lr, lid = li;
    for (int t = 0; t < 33; ++t) { pw[t] = (f32x2){(float)wr, (float)wi}; const double nwr = wr * lrd - wi * lid, nwi = wr * lid + wi * lrd; wr = nwr; wi = nwi; }
    f32x2* bb = (f32x2*)(a.ws + WS_BB) + (size_t)idx * 16;
    const float* bre = a.in[I_BRE] + (size_t)idx * 16; const float* bim = a.in[I_BIM] + (size_t)idx * 16;
    for (int n = 0; n < 16; ++n) { const float br = bre[n], bi = bim[n]; bb[n] = (f32x2){fr * br - fi * bi, fr * bi + fi * br}; }
}
__device__ __forceinline__ void kt_entry(const Args& a, int idx) {
    const int ni = idx & 15, tau = (idx >> 4) & 31, no = (idx >> 9) & 15, lg = idx >> 13;
    const float* cre = a.in[I_CRE] + ((size_t)lg * 16 + no) * 64; const float* cim = a.in[I_CIM] + ((size_t)lg * 16 + no) * 64;
    const f32x2* pw = (const f32x2*)(a.ws + WS_PW) + (size_t)lg * 64 * 33 + tau; const f32x2* bb = (const f32x2*)(a.ws + WS_BB) + (size_t)lg * 64 * 16 + ni;
    float s = 0.f;
#pragma unroll 8
    for (int p = 0; p < 64; ++p) { const f32x2 w = pw[p * 33], b = bb[p * 16]; const float cr = cre[p], ci = cim[p];
        const float er = cr * w.x - ci * w.y, ei = cr * w.y + ci * w.x; s += er * b.x - ei * b.y; }
    ((float*)(a.ws + WS_KT))[idx] = s;
}
__device__ __forceinline__ void coef_entry(const Args& a, int idx) {
    const int d = idx & 1023, b = (idx >> 10) & 1, s = idx >> 11, l = s / 3, sub = s % 3;
    const float* mp = (const float*)(a.ws + WS_MODP) + (size_t)l * 2 * MODW + (size_t)b * MODW + sub * 3 * D + d;
    float sh = 0.f, sc = 0.f, gt = 0.f;
    for (int kc = 0; kc < 8; ++kc) { const float* q = mp + (size_t)kc * 4 * MODW; sh += q[0]; sc += q[D]; gt += q[2 * D]; }
    const float* mb = a.in[I_MODB] + (size_t)l * MODW + sub * 3 * D + d; sh += mb[0]; sc += mb[D]; gt += mb[2 * D];
    float* co = (float*)(a.ws + WS_COEF) + ((size_t)(s * 2 + b) * 3) * D + d;
    co[0] = (sub == 1 ? 1.0f : 0.5f) * gt * a.in[I_NPOST][s * D + d];
    co[D] = a.in[I_NPRE][s * D + d] * (1.f + sc);
    co[2 * D] = sh;
}
__device__ __forceinline__ void prenorm_row(const float* __restrict__ xrow, const float* __restrict__ cb, bf16_t* __restrict__ orow, int lane) {
    const f32x4* xr = (const f32x4*)xrow + lane; f32x4 v[4]; float ss = 0.f;
#pragma unroll
    for (int j = 0; j < 4; ++j) { v[j] = xr[64 * j]; ss += (v[j].x * v[j].x + v[j].y * v[j].y) + (v[j].z * v[j].z + v[j].w * v[j].w); }
    const float r = rsqrtf(wave_sum(ss) * (1.f / D) + 1e-6f);
    u32x2* o8 = (u32x2*)orow + lane;
#pragma unroll
    for (int j = 0; j < 4; ++j) { const f32x4 B = *((const f32x4*)cb + 64 * j + lane), C = *((const f32x4*)(cb + D) + 64 * j + lane); const f32x4 o = v[j] * r * B + C;
        u32x2 w; w.x = cvt_pk(o.x, o.y); w.y = cvt_pk(o.z, o.w); o8[64 * j] = w; }
}
__device__ __forceinline__ void postnorm_row(const float* __restrict__ xi, float* __restrict__ xo, const float* __restrict__ yrow, const float* __restrict__ ca, const float* __restrict__ cbn, bf16_t* __restrict__ xn, int lane) {
    f32x4 v[4], y[4]; float ss = 0.f;
#pragma unroll
    for (int j = 0; j < 4; ++j) { y[j] = *((const f32x4*)yrow + 64 * j + lane); v[j] = *((const f32x4*)xi + 64 * j + lane); ss += (y[j].x * y[j].x + y[j].y * y[j].y) + (y[j].z * y[j].z + y[j].w * y[j].w); }
    const float r = rsqrtf(wave_sum(ss) * (1.f / D) + 1e-6f); float s2 = 0.f;
#pragma unroll
    for (int j = 0; j < 4; ++j) { const f32x4 A = *((const f32x4*)ca + 64 * j + lane); v[j] = v[j] + A * (y[j] * r); *((f32x4*)xo + 64 * j + lane) = v[j];
        s2 += (v[j].x * v[j].x + v[j].y * v[j].y) + (v[j].z * v[j].z + v[j].w * v[j].w); }
    if (xn) { const float r2 = rsqrtf(wave_sum(s2) * (1.f / D) + 1e-6f); u32x2* o8 = (u32x2*)xn + lane;
#pragma unroll
        for (int j = 0; j < 4; ++j) { const f32x4 B = *((const f32x4*)cbn + 64 * j + lane), C = *((const f32x4*)(cbn + D) + 64 * j + lane); const f32x4 o = v[j] * r2 * B + C;
            u32x2 w; w.x = cvt_pk(o.x, o.y); w.y = cvt_pk(o.z, o.w); o8[64 * j] = w; } }
}
}
namespace mk {
#define XB_TMO      128
#define XB_XCNT(j)  (256  + 64 * (j))
#define XB_XSUB(j)  (1280 + 64 * (j))
#define XB_XGEN(j)  (2304 + 64 * (j))
#define XB_TOP      3328
#define XB_TOPGEN   3392
#define XCD_BAR_WORDS 3456
#define XB_SPIN_CAP (1u << 18)

__device__ __forceinline__ unsigned xb_ld(unsigned* p)              { return __hip_atomic_load(p, __ATOMIC_RELAXED, __HIP_MEMORY_SCOPE_AGENT); }
__device__ __forceinline__ unsigned xb_add(unsigned* p, unsigned v) { return __hip_atomic_fetch_add(p, v, __ATOMIC_RELAXED, __HIP_MEMORY_SCOPE_AGENT); }
__device__ __forceinline__ unsigned xb_xcc_id() { return (unsigned)__builtin_amdgcn_s_getreg((3 << 11) | 20) & 0xFu; }
#define XB_SPIN(cond, bar) do { unsigned _sp = 0; while (cond) { __builtin_amdgcn_s_sleep(1); \
    if ((++_sp & 255u) == 0u) { if (xb_ld(&(bar)[XB_TMO])) break; if (_sp > XB_SPIN_CAP) { atomicAdd(&(bar)[XB_TMO], 1u); break; } } } } while (0)

struct XcdBarrier {
    unsigned* bar; unsigned x;
    volatile LAS unsigned* st;
};

__device__ __forceinline__ XcdBarrier xcd_barrier_post(unsigned* bar, volatile LAS unsigned* st) {
    XcdBarrier b; b.bar = bar; b.x = xb_xcc_id(); b.st = st;
    if (threadIdx.x == 0) (void)xb_add(&bar[XB_XCNT(b.x)], 1u);
    return b;
}
__device__ __forceinline__ void xcd_barrier_complete(unsigned* bar, unsigned x, unsigned& nloc, unsigned& nx) {
    const unsigned G = gridDim.x * gridDim.y * gridDim.z;
    unsigned sum, cnt, mine, sp = 0u;
    for (;;) {
        sum = 0u; cnt = 0u; mine = 0u;
#pragma unroll
        for (unsigned j = 0; j < 16; ++j) { const unsigned c = xb_ld(&bar[XB_XCNT(j)]); sum += c; cnt += (c > 0u) ? 1u : 0u; mine = (j == x) ? c : mine; }
        if (sum == G) break;
        __builtin_amdgcn_s_sleep(1);
        if ((++sp & 255u) == 0u) { if (xb_ld(&bar[XB_TMO])) break; if (sp > XB_SPIN_CAP) { atomicAdd(&bar[XB_TMO], 1u); break; } }
    }
    nloc = mine > 0u ? mine : 1u; nx = cnt > 0u ? cnt : 1u;
}

__device__ __forceinline__ void xcd_barrier(const XcdBarrier& b) {
    asm volatile("s_waitcnt vmcnt(0)" ::: "memory");
    __syncthreads();
    if (threadIdx.x == 0) {
        unsigned* bar = b.bar;
        __builtin_amdgcn_s_waitcnt(0);
        unsigned nloc = b.st[0], nx = b.st[1];
        if (nloc == 0u) { xcd_barrier_complete(bar, b.x, nloc, nx); b.st[0] = nloc; b.st[1] = nx; }
        const unsigned old = xb_add(&bar[XB_XSUB(b.x)], 1u);
        const unsigned gen = old / nloc;
        if (old + 1u == (gen + 1u) * nloc) {
            __builtin_amdgcn_fence(__ATOMIC_RELEASE, "agent");
            asm volatile("s_waitcnt vmcnt(0)" ::: "memory");
            const unsigned og = xb_add(&bar[XB_TOP], 1u);
            const unsigned tg = og / nx;
            if (og + 1u == (tg + 1u) * nx) xb_add(&bar[XB_TOPGEN], 1u);
            else XB_SPIN(xb_ld(&bar[XB_TOPGEN]) == tg, bar);
            __builtin_amdgcn_fence(__ATOMIC_ACQUIRE, "agent");
            xb_add(&bar[XB_XGEN(b.x)], 1u);
            asm volatile("s_waitcnt vmcnt(0)" ::: "memory");
        } else {
            XB_SPIN(xb_ld(&bar[XB_XGEN(b.x)]) == gen, bar);
            __builtin_amdgcn_fence(__ATOMIC_ACQUIRE, "agent");
            asm volatile("s_waitcnt vmcnt(0)" ::: "memory");
        }
    }
    __syncthreads();
}

}
namespace mk {
__device__ __forceinline__ u32x4 pack8(const f32x4 a, const f32x4 b) { u32x4 w; w.x = cvt_pk(a[0], a[1]); w.y = cvt_pk(a[2], a[3]); w.z = cvt_pk(b[0], b[1]); w.w = cvt_pk(b[2], b[3]); return w; }
__device__ __forceinline__ void unpack8(const u32x4 w, f32x4& a, f32x4& b) { a = (f32x4){bf_lo(w.x), bf_hi(w.x), bf_lo(w.y), bf_hi(w.y)}; b = (f32x4){bf_lo(w.z), bf_hi(w.z), bf_lo(w.w), bf_hi(w.w)}; }
__device__ __forceinline__ float log2_sigmoid(float x) { return LOG2E * fminf(x, 0.f) - __builtin_amdgcn_logf(1.f + __builtin_amdgcn_exp2f(-LOG2E * fabsf(x))); }

struct EpiInProj {
    static constexpr bool PERM = true, AFTER_DRAIN = false;
    bf16_t *UG, *Q, *SGA; float* LF; const float* fb;
    static_assert(WS_K - WS_Q == 16 * MiB && WS_V - WS_K == 16 * MiB && WS_SGB - WS_SGA == 32 * MiB, "EpiInProj pointer arithmetic");
    __device__ __forceinline__ void operator()(const f32x4 (&acc)[2][2][4][2], const Unit& u, int wr, int wc, int fr, int fq) const {
        const int row0 = u.pm * 256 + wr * 64 + fr, pn = u.pn;
#pragma unroll
        for (int ai = 0; ai < 2; ++ai)
#pragma unroll
            for (int m = 0; m < 4; ++m) {
                const int row = row0 + ai * 128 + m * 16;
#pragma unroll
                for (int bj = 0; bj < 2; ++bj) {
                    const int c8 = 128 * bj + 32 * wc + 8 * fq; const f32x4 v0 = acc[ai][bj][m][0], v1 = acc[ai][bj][m][1];
                    if (pn < 2) { const int col = 256 * pn + c8, g = col >> 4, ch0 = col & 15, chunk = row >> 5, i = row & 31;
                        *(u32x4*)(UG + ((size_t)(g * NCH + chunk) * UGK + i * 16 + ch0)) = pack8(v0, v1); }
                    else if (pn < 8) { const int which = (pn - 2) >> 1, col = 256 * ((pn - 2) & 1) + c8; bf16_t* base = Q + (size_t)which * (16 * MiB / 2); const float sc = which == 0 ? QSCALE : 1.f;
                        *(u32x4*)(base + (size_t)row * 512 + col) = pack8(v0 * sc, v1 * sc); }
                    else if (pn < 16) { bf16_t* base = SGA + (size_t)(pn >= 12 ? 1 : 0) * (32 * MiB / 2); const int col = 256 * ((pn - 8) & 3) + c8;
                        f32x4 s0, s1;
#pragma unroll
                        for (int e = 0; e < 4; ++e) { s0[e] = fast_sigmoid(v0[e]); s1[e] = fast_sigmoid(v1[e]); }
                        *(u32x4*)(base + (size_t)row * 1024 + col) = pack8(s0, s1); }
                    else { if (bj == 0 && wc == 0 && fq == 0) { f32x4 l0, l1;
#pragma unroll
                            for (int e = 0; e < 4; ++e) { l0[e] = log2_sigmoid(v0[e] + fb[e]); l1[e] = log2_sigmoid(v1[e] + fb[4 + e]); }
                            *(f32x4*)(LF + (size_t)row * 8) = l0; *(f32x4*)(LF + (size_t)row * 8 + 4) = l1; } }
                }
            }
    }
};
struct EpiLocal {
    static constexpr bool PERM = false, AFTER_DRAIN = false;
    float* LOCAL;
    __device__ __forceinline__ void operator()(const f32x4 (&acc)[2][2][4][2], const Unit& u, int wr, int wc, int fr, int fq) const {
        const int g = u.pn, chunk0 = (u.pm & 1) * 256 + wr * 64 + fr;
#pragma unroll
        for (int ai = 0; ai < 2; ++ai)
#pragma unroll
            for (int m = 0; m < 4; ++m) { float* rowp = LOCAL + ((size_t)(chunk0 + ai * 128 + m * 16) * G + g) * 128 + wc * 32 + 4 * fq;
#pragma unroll
                for (int n = 0; n < 2; ++n) *(f32x4*)(rowp + n * 16) = acc[ai][0][m][n]; }
    }
};
struct EpiSsmY {
    static constexpr bool PERM = true, AFTER_DRAIN = false;
    const bf16_t* UG; bf16_t* YS; const float* dsk;
    __device__ __forceinline__ void operator()(const f32x4 (&acc)[2][2][4][2], const Unit& u, int wr, int wc, int fr, int fq) const {
        const int g = u.pm >> 1, nj = u.pn & 1, chunk0 = (u.pm & 1) * 256 + wr * 64 + fr, no0 = 8 * (fq & 1);
        const f32x4 d0 = *(const f32x4*)(dsk + g * 16 + no0), d1 = *(const f32x4*)(dsk + g * 16 + no0 + 4);
#pragma unroll
        for (int ai = 0; ai < 2; ++ai)
#pragma unroll
            for (int m = 0; m < 4; ++m) { const int chunk = chunk0 + ai * 128 + m * 16;
#pragma unroll
                for (int bj = 0; bj < 2; ++bj) { const int j = nj * 16 + 8 * bj + 2 * wc + (fq >> 1);
                    const u32x4 uw = *(const u32x4*)(UG + ((size_t)(g * NCH + chunk) * UGK + j * 16 + no0)); f32x4 u0, u1; unpack8(uw, u0, u1);
                    f32x4 y0 = acc[ai][bj][m][0] + d0 * u0, y1 = acc[ai][bj][m][1] + d1 * u1;
#pragma unroll
                    for (int e = 0; e < 4; ++e) { y0[e] = fast_gelu_tanh(y0[e]); y1[e] = fast_gelu_tanh(y1[e]); }
                    *(u32x4*)(YS + ((size_t)(chunk * TC + j) * 512 + g * 16 + no0)) = pack8(y0, y1); } }
    }
};
struct EpiAO {
    static constexpr bool PERM = true, AFTER_DRAIN = false;
    const bf16_t* SGB; bf16_t* YBG;
    __device__ __forceinline__ void operator()(const f32x4 (&acc)[2][2][4][2], const Unit& u, int wr, int wc, int fr, int fq) const {
        const int row0 = u.pm * 256 + wr * 64 + fr, col0 = u.pn * 256 + wc * 32 + 8 * fq;
#pragma unroll
        for (int ai = 0; ai < 2; ++ai)
#pragma unroll
            for (int m = 0; m < 4; ++m)
#pragma unroll
                for (int bj = 0; bj < 2; ++bj) { const size_t off = (size_t)(row0 + ai * 128 + m * 16) * D + col0 + bj * 128;
                    f32x4 s0, s1; unpack8(*(const u32x4*)(SGB + off), s0, s1);
                    *(u32x4*)(YBG + off) = pack8(acc[ai][bj][m][0] * s0, acc[ai][bj][m][1] * s1); }
    }
};
struct EpiGLU {
    static constexpr bool PERM = true, AFTER_DRAIN = false;
    const bf16_t *SGA, *YBG; bf16_t* MG;
    __device__ __forceinline__ void operator()(const f32x4 (&acc)[2][2][4][2], const Unit& u, int wr, int wc, int fr, int fq) const {
        const int row0 = u.pm * 256 + wr * 64 + fr, col0 = u.pn * 128 + wc * 32 + 8 * fq;
#pragma unroll
        for (int ai = 0; ai < 2; ++ai)
#pragma unroll
            for (int m = 0; m < 4; ++m) { const size_t off = (size_t)(row0 + ai * 128 + m * 16) * D + col0;
                f32x4 s0, s1, b0, b1; unpack8(*(const u32x4*)(SGA + off), s0, s1); unpack8(*(const u32x4*)(YBG + off), b0, b1);
                const f32x4 v0 = acc[ai][0][m][0], v1 = acc[ai][0][m][1], g0 = acc[ai][1][m][0], g1 = acc[ai][1][m][1]; f32x4 o0, o1;
#pragma unroll
                for (int e = 0; e < 4; ++e) { o0[e] = v0[e] * fast_sigmoid(g0[e]) * s0[e] + b0[e]; o1[e] = v1[e] * fast_sigmoid(g1[e]) * s1[e] + b1[e]; }
                *(u32x4*)(MG + off) = pack8(o0, o1); }
    }
};
struct LocalOrder { int c; __device__ __forceinline__ bool next(int i, Unit& u) const { if (i > 0 || c < 0 || c >= 64) return false; u.pm = c; u.pn = c >> 1; return true; }
    __device__ __forceinline__ void a_ready(const Unit&) const {} __device__ __forceinline__ void done(const Unit&) const {} };
struct SsmYOrder { int c; __device__ __forceinline__ bool next(int i, Unit& u) const { if (i > 0 || c < 0 || c >= 128) return false; const int g = c >> 2; u.pm = g * 2 + ((c >> 1) & 1); u.pn = g * 2 + (c & 1); return true; }
    __device__ __forceinline__ void a_ready(const Unit&) const {} __device__ __forceinline__ void done(const Unit&) const {} };

__device__ __forceinline__ void ssm_mat_item(const Args& a, int l, int r, int lane) {
    unsigned char* ws = a.ws;
    const f32x2* PWt = (const f32x2*)(ws + WS_PW); const f32x2* BBt = (const f32x2*)(ws + WS_BB); const float* KT = (const float*)(ws + WS_KT);
    if (r < 16384) {
        const int g = r >> 9, j = (r >> 4) & 31, no = r & 15, lg = l * 32 + g;
        bf16_t* dst = (bf16_t*)(ws + WS_BTY) + (size_t)r * UGK;
        { const int i = lane >> 1, ni0 = (lane & 1) * 8; u32x4 w = {0u, 0u, 0u, 0u};
          if (i <= j) { const float* src = KT + ((((size_t)lg * 16 + no) * 32 + (j - i)) * 16 + ni0); w = pack8(*(const f32x4*)src, *(const f32x4*)(src + 4)); }
          *(u32x4*)(dst + 8 * lane) = w; }
        if (lane < 16) { const int part = lane >> 3, p0 = (lane & 7) * 8; float v[8];
#pragma unroll
            for (int e = 0; e < 8; ++e) { const int p = p0 + e; const float cr = a.in[I_CRE][((size_t)lg * 16 + no) * 64 + p], ci = a.in[I_CIM][((size_t)lg * 16 + no) * 64 + p]; const f32x2 w = PWt[((size_t)lg * 64 + p) * 33 + j + 1];
                v[e] = part ? -(cr * w.y + ci * w.x) : (cr * w.x - ci * w.y); }
            *(u32x4*)(dst + 512 + 8 * lane) = pack8((f32x4){v[0], v[1], v[2], v[3]}, (f32x4){v[4], v[5], v[6], v[7]}); }
    } else {
        r -= 16384;
        const int g = r >> 8, rr = r & 255, lg = l * 32 + g;
        bf16_t* dst = (bf16_t*)(ws + WS_BTF) + (size_t)r * 512;
        u32x4 w = {0u, 0u, 0u, 0u};
        if (rr < 128) { const int p = rr & 63, part = rr >> 6, i = lane >> 1, ni0 = (lane & 1) * 8; const f32x2 pw = PWt[((size_t)lg * 64 + p) * 33 + 31 - i]; float v[8];
#pragma unroll
            for (int e = 0; e < 8; ++e) { const f32x2 bb = BBt[((size_t)lg * 64 + p) * 16 + ni0 + e]; v[e] = part ? (pw.x * bb.y + pw.y * bb.x) : (pw.x * bb.x - pw.y * bb.y); }
            w = pack8((f32x4){v[0], v[1], v[2], v[3]}, (f32x4){v[4], v[5], v[6], v[7]}); }
        *(u32x4*)(dst + 8 * lane) = w;
    }
}
constexpr int SSM_MAT_ITEMS = 16384 + 8192;

__device__ __forceinline__ void cum_block(const float* __restrict__ LF, float* __restrict__ CUM, int bh, LAS float* red, int tid) {
    const int b = bh >> 3, h = bh & 7, t0 = tid * 16, lane = tid & 63, wv = tid >> 6;
    const float* lf = LF + ((size_t)b * L + t0) * 8 + h;
    float v[16]; float s = 0.f;
#pragma unroll
    for (int i = 0; i < 16; ++i) { v[i] = lf[i * 8]; s += v[i]; }
    float inc = s;
#pragma unroll
    for (int o = 1; o < 64; o <<= 1) { const float t = __shfl_up(inc, o); if (lane >= o) inc += t; }
    if (lane == 63) red[wv] = inc;
    __syncthreads();
    float base = 0.f;
#pragma unroll
    for (int w = 0; w < 8; ++w) base += (w < wv) ? red[w] : 0.f;
    float run = base + inc - s;
    float* dst = CUM + (size_t)bh * L + t0;
#pragma unroll
    for (int i = 0; i < 16; i += 4) { f32x4 o; run += v[i]; o[0] = run; run += v[i + 1]; o[1] = run; run += v[i + 2]; o[2] = run; run += v[i + 3]; o[3] = run; *(f32x4*)(dst + i) = o; }
    __syncthreads();
}
__device__ __forceinline__ void carry_scan(const Args& a, int l, int idx) {
    const int b = idx >> 11, g = (idx >> 6) & 31, p = idx & 63;
    const f32x2 aw = ((const f32x2*)(a.ws + WS_PW))[((size_t)(l * 32 + g) * 64 + p) * 33 + 32];
    const float* loc = (const float*)(a.ws + WS_LOCAL) + ((size_t)(b * 256) * G + g) * 128 + p;
    bf16_t* ug = (bf16_t*)(a.ws + WS_UG) + ((size_t)(g * NCH + b * 256)) * UGK + 512 + p;
    float sr = 0.f, si = 0.f;
#pragma unroll 8
    for (int c = 0; c < 256; ++c) {
        const float lr = loc[(size_t)c * G * 128], li = loc[(size_t)c * G * 128 + 64];
        ug[(size_t)c * UGK] = (bf16_t)(cvt_pk(sr, 0.f) & 0xffffu); ug[(size_t)c * UGK + 64] = (bf16_t)(cvt_pk(si, 0.f) & 0xffffu);
        const float nr = aw.x * sr - aw.y * si + lr, ni = aw.x * si + aw.y * sr + li; sr = nr; si = ni;
    }
}
}
#include <hip/hip_bf16.h>
#include <cmath>
namespace attn_body {
using bf16=__hip_bfloat16;
using bf16x8=__attribute__((ext_vector_type(8)))short;
using s16x4=__attribute__((ext_vector_type(4)))short;
using f32x16=__attribute__((ext_vector_type(16)))float;
using u32x4=__attribute__((ext_vector_type(4)))unsigned;
constexpr int BATCH=2,NHEAD=8,SEQ=8192,D=64,DM=NHEAD*D;
constexpr int NW=8,QBLK=32,QB=QBLK*NW,KVBLK=64,NQB=SEQ/QB;
constexpr int ATTN_PITCH=DM, ATTN_UNIT_ROWS=QB;
__device__ __forceinline__ int crow(int r,int hi){return (r&3)+8*(r>>2)+4*hi;}
#define SBAR() __builtin_amdgcn_sched_barrier(0)
__device__ __forceinline__ void cmask(f32x16&p0,f32x16&p1,int jb,int qrel,int hi){
  const float NEG=-INFINITY; int kb=64*jb+4*hi;
  #pragma unroll
  for(int r=0;r<16;++r){int kv=kb+(r&3)+8*(r>>2); if(kv>qrel)p0[r]=NEG; if(kv+32>qrel)p1[r]=NEG;}
}

constexpr int NSLOT=3, SLOTB=8192;
constexpr int LDS_K=0, LDS_V=NSLOT*SLOTB, LDS_WS=2*NSLOT*SLOTB, LDS_OST=LDS_WS+NW*64*4, LDS_CK=LDS_OST+NW*4096, LDS_BYTES=LDS_CK+SEQ*4;
constexpr float C2=0.125f*1.4426950408889634f;
__device__ __forceinline__ void glds16(const void*gsrc,unsigned lds_dst){unsigned keep;
  asm volatile("s_mov_b32 %0, m0\n\ts_mov_b32 m0, %2\n\ts_nop 0\n\tglobal_load_lds_dwordx4 %1, off\n\ts_mov_b32 m0, %0":"=&s"(keep):"v"(gsrc),"s"(lds_dst):"memory");}
__device__ __forceinline__ float max3f(float a,float b,float c){float r;asm("v_max3_f32 %0, %1, %2, %3":"=v"(r):"v"(a),"v"(b),"v"(c));return r;}
__device__ __forceinline__ float max2f(float a,float b){float r;asm("v_max_f32_e32 %0, %1, %2":"=v"(r):"v"(a),"v"(b));return r;}
__device__ __forceinline__ float fadd_s(float a,float b){float r;asm("v_add_f32_e32 %0, %1, %2":"=v"(r):"v"(a),"v"(b));return r;}
__device__ __forceinline__ float fsub_s(float a,float b){float r;asm("v_sub_f32_e32 %0, %1, %2":"=v"(r):"v"(a),"v"(b));return r;}
typedef float f32x2_t __attribute__((ext_vector_type(2))); typedef __bf16 bf16x2_t __attribute__((ext_vector_type(2)));
__device__ __forceinline__ unsigned cvtpk_s(float lo,float hi){f32x2_t v={lo,hi};bf16x2_t b=__builtin_convertvector(v,bf16x2_t);return __builtin_bit_cast(unsigned,b);}
#define WAIT_BAR(N) asm volatile("s_waitcnt vmcnt(" #N ") lgkmcnt(0)\n\ts_barrier":::"memory")

__device__ __forceinline__ void qkt(f32x16&p0,f32x16&p1,const char*Kslot,const bf16x8*qr,bf16x8 ka0,bf16x8 ka1,bf16x8 qaug,int r32,int hi){
  const char*kb=Kslot+hi*1024+r32*16;
  const f32x16 z=f32x16{};
  #pragma unroll
  for(int d0=0;d0<4;++d0){
    const bf16x8 b0=*reinterpret_cast<const bf16x8*>(kb+d0*2048);
    const bf16x8 b1=*reinterpret_cast<const bf16x8*>(kb+d0*2048+512);
    if(d0==0){p0=__builtin_amdgcn_mfma_f32_32x32x16_bf16(b0,qr[0],z,0,0,0);p1=__builtin_amdgcn_mfma_f32_32x32x16_bf16(b1,qr[0],z,0,0,0);}
    else{p0=__builtin_amdgcn_mfma_f32_32x32x16_bf16(b0,qr[d0],p0,0,0,0);p1=__builtin_amdgcn_mfma_f32_32x32x16_bf16(b1,qr[d0],p1,0,0,0);}}
  p0=__builtin_amdgcn_mfma_f32_32x32x16_bf16(ka0,qaug,p0,0,0,0);p1=__builtin_amdgcn_mfma_f32_32x32x16_bf16(ka1,qaug,p1,0,0,0);
}
typedef __attribute__((address_space(3))) const char* lds_cptr;
typedef short v4i16_t __attribute__((ext_vector_type(4)));
__device__ __forceinline__ void kload8(bf16x8*kf,lds_cptr kp){
  kf[0]=*(const __attribute__((address_space(3))) bf16x8*)(kp);      kf[1]=*(const __attribute__((address_space(3))) bf16x8*)(kp+512);
  kf[2]=*(const __attribute__((address_space(3))) bf16x8*)(kp+2048); kf[3]=*(const __attribute__((address_space(3))) bf16x8*)(kp+2560);
  kf[4]=*(const __attribute__((address_space(3))) bf16x8*)(kp+4096); kf[5]=*(const __attribute__((address_space(3))) bf16x8*)(kp+4608);
  kf[6]=*(const __attribute__((address_space(3))) bf16x8*)(kp+6144); kf[7]=*(const __attribute__((address_space(3))) bf16x8*)(kp+6656);
}
__device__ __forceinline__ void kload2(bf16x8*kf,lds_cptr kp,int j){ kf[2*j]=*(const __attribute__((address_space(3))) bf16x8*)(kp+j*2048); kf[2*j+1]=*(const __attribute__((address_space(3))) bf16x8*)(kp+j*2048+512); }
__device__ __forceinline__ s16x4 vtr(lds_cptr p){ return __builtin_bit_cast(s16x4,__builtin_amdgcn_ds_read_tr16_b64_v4i16((__attribute__((address_space(3))) v4i16_t*)p)); }
__device__ __forceinline__ float rowmax(const f32x16&p0,const f32x16&p1){
  float a=max3f(p0[0],p0[1],p1[0]),b=max3f(p0[2],p0[3],p1[1]);a=max3f(a,p1[2],p1[3]);
  #pragma unroll
  for(int r=4;r<16;r+=4){a=max3f(a,p0[r],p0[r+1]);b=max3f(b,p0[r+2],p0[r+3]);a=max3f(a,p1[r],p1[r+1]);b=max3f(b,p1[r+2],p1[r+3]);}
  const float m=max2f(a,b);
  auto rr=__builtin_amdgcn_permlane32_swap(__float_as_uint(m),__float_as_uint(m),false,false);
  return max2f(__uint_as_float(rr[0]),__uint_as_float(rr[1]));
}
__device__ __forceinline__ void pv(f32x16*o,int vb,bf16x8 pa0,bf16x8 pa1,bf16x8 pa2,bf16x8 pa3){
  #pragma unroll
  for(int d0=0;d0<2;++d0){s16x4 lo[4],hi[4];
    #pragma unroll
    for(int ks=0;ks<4;++ks){
      asm volatile("ds_read_b64_tr_b16 %0,%1 offset:%c2":"=&v"(lo[ks]):"v"(vb),"i"(d0*4096+ks*1024):"memory");
      asm volatile("ds_read_b64_tr_b16 %0,%1 offset:%c2":"=&v"(hi[ks]):"v"(vb),"i"(d0*4096+ks*1024+512):"memory");}
    asm volatile("s_waitcnt lgkmcnt(0)":::"memory");SBAR();
    #define PK(k) (bf16x8){lo[k][0],lo[k][1],lo[k][2],lo[k][3],hi[k][0],hi[k][1],hi[k][2],hi[k][3]}
    o[d0]=__builtin_amdgcn_mfma_f32_32x32x16_bf16(pa0,PK(0),o[d0],0,0,0);
    o[d0]=__builtin_amdgcn_mfma_f32_32x32x16_bf16(pa1,PK(1),o[d0],0,0,0);
    o[d0]=__builtin_amdgcn_mfma_f32_32x32x16_bf16(pa2,PK(2),o[d0],0,0,0);
    o[d0]=__builtin_amdgcn_mfma_f32_32x32x16_bf16(pa3,PK(3),o[d0],0,0,0);
    #undef PK
  }
}

#ifndef ATTN_STORE16
#define ATTN_STORE16(p,v) (*(u32x4*)(p)=(v))
#endif
template<int THRL> __device__ __forceinline__ void attn_unit(int b,int h,int qb,const bf16*Q,const bf16*__restrict__ K,const bf16*__restrict__ V,bf16*O,const float*__restrict__ CUM,char*shm){
  int tid_=threadIdx.x; asm volatile("":"+v"(tid_)); const int tid=tid_,lane=tid&63,r32=lane&31,hi=lane>>5; const int wid=__builtin_amdgcn_readfirstlane(tid>>6);
  const long rowbase=(long)b*SEQ; const int q0=qb*QB;
  const bf16*Qw=Q+(rowbase+q0+wid*QBLK)*DM+h*D;
  const bf16*Kh=K+rowbase*DM+h*D,*Vh=V+rowbase*DM+h*D;
  const unsigned lds0=(unsigned)(uintptr_t)shm;
  float*wsf=(float*)(shm+LDS_WS)+wid*64;
  const bf16*ksrc=Kh+(long)lane*DM+wid*8;
  const bf16*vsrc=Vh+(long)(16*(wid&3)+(lane>>2))*DM+(wid>>2)*32+(lane&3)*8;
  const unsigned kdst=lds0+LDS_K+wid*1024, vdst=lds0+LDS_V+wid*1024;
  #define DMA_K(t,slot) glds16(ksrc+(long)(t)*KVBLK*DM,(unsigned)__builtin_amdgcn_readfirstlane(kdst+(slot)))
  #define DMA_V(t,slot) glds16(vsrc+(long)(t)*KVBLK*DM,(unsigned)__builtin_amdgcn_readfirstlane(vdst+(slot)))
  const int vb0=(int)(lds0+LDS_V)+((lane>>4)&1)*32+(lane&3)*8+(4*hi+((lane&15)>>2))*64;
  const char*Kbase=shm+LDS_K; bf16x8 kf[8];
  const lds_cptr shm3=(lds_cptr)shm; const lds_cptr kp0=shm3+LDS_K+hi*1024+r32*16; const lds_cptr vp0=shm3+LDS_V+((lane>>4)&1)*32+(lane&3)*8+(4*hi+((lane&15)>>2))*64;
  const int NT=(q0+QB)/KVBLK;
  const __attribute__((address_space(3))) unsigned* ckp=(const __attribute__((address_space(3))) unsigned*)(shm3+LDS_CK);
  { const float*cb=CUM+((long)b*NHEAD+h)*SEQ; const float cref=cb[q0];
    for(int i=tid;i<q0+QB;i+=512){ const float rel=cb[i]-cref; const unsigned hb=cvtpk_s(rel,0.f)&0xffffu; const float hf=__uint_as_float(hb<<16); const unsigned lb=cvtpk_s(rel-hf,0.f)&0xffffu;
      ((__attribute__((address_space(3))) unsigned*)(shm3+LDS_CK))[i]=hb|(lb<<16); }
    asm volatile("s_waitcnt vmcnt(0) lgkmcnt(0)":::"memory"); }
  const unsigned one2=hi?0u:0x3f803f80u, neg2=hi?0u:0xbf80bf80u;
  #define KAUG(w) __builtin_bit_cast(bf16x8,(u32x4){hi?0u:(w),one2,0u,0u})
  #define QAUG() __builtin_bit_cast(bf16x8,(u32x4){neg2,mpk,0u,0u})
  unsigned mpk=0u;
  #define SETM(m) do{ const unsigned hb_=cvtpk_s(m,0.f)&0xffffu; const float hf_=__uint_as_float(hb_<<16); const unsigned lb_=cvtpk_s((m)-hf_,0.f)&0xffffu; const float lf_=__uint_as_float(lb_<<16); \
      m=hf_+lf_; mpk=hi?0u:((hb_|(lb_<<16))^0x80008000u); }while(0)
  DMA_K(0,0);DMA_V(0,0);DMA_K(1,SLOTB);
  bf16x8 qr[4];
  #pragma unroll
  for(int d0=0;d0<4;++d0)qr[d0]=*reinterpret_cast<const bf16x8*>(&Qw[(long)r32*DM+d0*16+hi*8]);
  float mhat=0.f,l_reg=0.f;f32x16 o[2];o[0]=f32x16{};o[1]=f32x16{};
  const int qrel=wid*QBLK+r32;
  #define CMASK(P0,P1,t) do{int jb_=(t)-(NT-4); if(jb_>=0)cmask(P0,P1,jb_,qrel,hi);}while(0)
  bool resc=false;
  #define START(P0,P1) do{ const float rm=rowmax(P0,P1); resc=false; \
    { mhat=rm; SETM(mhat); const float dl=mhat; \
      _Pragma("unroll") for(int r=0;r<16;++r){P0[r]=fsub_s(P0[r],dl);P1[r]=fsub_s(P1[r],dl);} } \
    _Pragma("unroll") for(int r=0;r<16;++r)P0[r]=__builtin_amdgcn_exp2f(P0[r]); }while(0)
  #define RESC() do{ if(resc){ asm volatile("s_waitcnt lgkmcnt(0)":::"memory"); \
      _Pragma("unroll") for(int d_=0;d_<2;++d_) _Pragma("unroll") for(int r=0;r<16;++r)o[d_][r]*=wsf[crow(r,hi)]; } }while(0)
  f32x16 pA0,pA1,pB0,pB1;
  int sl_prev=0,sl_cur=0,sl_next=SLOTB;
  #define ROT() do{sl_prev=sl_cur;sl_cur=sl_next;sl_next=(sl_next==(NSLOT-1)*SLOTB)?0:sl_next+SLOTB;}while(0)
  DMA_K(2,2*SLOTB);
  WAIT_BAR(3);
  { const unsigned w0=ckp[r32],w1=ckp[32+r32]; qkt(pA0,pA1,Kbase,qr,KAUG(w0),KAUG(w1),QAUG(),r32,hi); }asm volatile("s_nop 15\n\ts_nop 7":"+v"(pA0),"+v"(pA1));CMASK(pA0,pA1,0);
  START(pA0,pA1);
  _Pragma("unroll") for(int r=0;r<16;++r)pA1[r]=__builtin_amdgcn_exp2f(pA1[r]);
  WAIT_BAR(0);
  DMA_K(3,0);DMA_V(1,SLOTB);
  ROT();
  kload8(kf,kp0+sl_cur);
  WAIT_BAR(2);
  s16x4 vlo[8],vhi[8]; u32x4 pw0,pw1,pw2,pw3;
  #define PKW(P,B) cvtpk_s(P[B],P[B+1])
  #define PAF(k) __builtin_bit_cast(bf16x8,pw##k)
  #define VFR(i) (bf16x8){vlo[i][0],vlo[i][1],vlo[i][2],vlo[i][3],vhi[i][0],vhi[i][1],vhi[i][2],vhi[i][3]}
  #define PIN(x) asm volatile("":"+v"(x))
  #define MX3(a,b,c) __builtin_fmaxf(__builtin_fmaxf((a),(b)),(c))
  #define GAPA(MF,A0,A1,A2,A3,W0,W1,PW) do{ MF; sacc+=A0; sacc+=A1; sacc+=A2; sacc+=A3; PIN(sacc); W0; W1; PIN(PW); SBAR(); }while(0)
  #define EX(v) __builtin_amdgcn_exp2f(v)
  #define GAPB(MF,X,B) do{ MF; X[B]=EX(X[B]); X[B+1]=EX(X[B+1]); X[B+2]=EX(X[B+2]); X[B+3]=EX(X[B+3]); PIN(X); SBAR(); }while(0)
  #define VRD(i) do{ vlo[i]=vtr(vp_+(((i)>>2)*4096+((i)&3)*1024)); vhi[i]=vtr(vp_+(((i)>>2)*4096+((i)&3)*1024+512)); }while(0)
  #define KRD(G,j) do{ if(G){ kload2(kf,kp0+sl_next,j); SBAR(); } }while(0)
  #define STEP(C0,C1,P0,P1,t,GK,GV,GL) do{ SBAR(); \
    const lds_cptr vp_=vp0+sl_prev; \
    const unsigned cw0_=ckp[(t)*64+r32],cw1_=ckp[(t)*64+32+r32]; const f32x16 z_=f32x16{}; \
    VRD(0); SBAR(); float sacc=(P0[0]+P0[1]); \
    GAPA(C0=__builtin_amdgcn_mfma_f32_32x32x16_bf16(kf[0],qr[0],z_,0,0,0), P0[2],P0[3],P0[4],P0[5],     pw0[0]=PKW(P0,0), pw0[1]=PKW(P0,2), pw0); \
    VRD(4); SBAR(); GAPA(C1=__builtin_amdgcn_mfma_f32_32x32x16_bf16(kf[1],qr[0],z_,0,0,0), P0[6],P0[7],P0[8],P0[9],     pw0[2]=PKW(P0,4), pw0[3]=PKW(P0,6), pw0); \
    VRD(1); SBAR(); GAPA(C0=__builtin_amdgcn_mfma_f32_32x32x16_bf16(kf[2],qr[1],C0,0,0,0),   P0[10],P0[11],P0[12],P0[13], pw1[0]=PKW(P0,8), pw1[1]=PKW(P0,10), pw1); \
    VRD(5); SBAR(); GAPA(C1=__builtin_amdgcn_mfma_f32_32x32x16_bf16(kf[3],qr[1],C1,0,0,0),   P0[14],P0[15],P1[0],P1[1],   pw1[2]=PKW(P0,12),pw1[3]=PKW(P0,14), pw1); \
    VRD(2); SBAR(); GAPA(C0=__builtin_amdgcn_mfma_f32_32x32x16_bf16(kf[4],qr[2],C0,0,0,0),   P1[2],P1[3],P1[4],P1[5],     pw2[0]=PKW(P1,0), pw2[1]=PKW(P1,2), pw2); \
    VRD(6); SBAR(); GAPA(C1=__builtin_amdgcn_mfma_f32_32x32x16_bf16(kf[5],qr[2],C1,0,0,0),   P1[6],P1[7],P1[8],P1[9],     pw2[2]=PKW(P1,4), pw2[3]=PKW(P1,6), pw2); \
    VRD(3); SBAR(); GAPA(C0=__builtin_amdgcn_mfma_f32_32x32x16_bf16(kf[6],qr[3],C0,0,0,0),   P1[10],P1[11],P1[12],P1[13], pw3[0]=PKW(P1,8), pw3[1]=PKW(P1,10), pw3); \
    VRD(7); SBAR(); GAPA(C1=__builtin_amdgcn_mfma_f32_32x32x16_bf16(kf[7],qr[3],C1,0,0,0),   P1[14],P1[15],0.f,0.f,       pw3[2]=PKW(P1,12),pw3[3]=PKW(P1,14), pw3); \
    C0=__builtin_amdgcn_mfma_f32_32x32x16_bf16(KAUG(cw0_),QAUG(),C0,0,0,0); C1=__builtin_amdgcn_mfma_f32_32x32x16_bf16(KAUG(cw1_),QAUG(),C1,0,0,0); SBAR(); \
    l_reg+=sacc; \
    if(GK){DMA_K((t)+3,sl_cur);} if(GV){DMA_V((t)+1,sl_next);} \
    CMASK(C0,C1,t); \
    { float a=MX3(C0[0],C0[1],C1[0]),b=MX3(C0[2],C0[3],C1[1]); a=MX3(a,C1[2],C1[3]); \
      _Pragma("unroll") for(int r=4;r<16;r+=4){a=MX3(a,C0[r],C0[r+1]);b=MX3(b,C0[r+2],C0[r+3]);a=MX3(a,C1[r],C1[r+1]);b=MX3(b,C1[r+2],C1[r+3]);} \
      float rm=__builtin_fmaxf(a,b); { auto rr=__builtin_amdgcn_permlane32_swap(__float_as_uint(rm),__float_as_uint(rm),false,false); rm=__builtin_fmaxf(__uint_as_float(rr[0]),__uint_as_float(rr[1])); } \
      resc=false; \
      if(__builtin_expect(__any(rm>(float)THRL),0)){ const float mold_=mhat; mhat+=__builtin_fmaxf(rm,0.f); SETM(mhat); const float dl=mhat-mold_; \
        _Pragma("unroll") for(int r=0;r<16;++r){C0[r]-=dl;C1[r]-=dl;} \
        const float f=__builtin_amdgcn_exp2f(-dl); l_reg*=f; if(hi==0)wsf[r32]=f; resc=true; } } \
    SBAR(); \
    GAPB(o[0]=__builtin_amdgcn_mfma_f32_32x32x16_bf16(PAF(0),VFR(0),o[0],0,0,0), C0,0); \
    GAPB(o[1]=__builtin_amdgcn_mfma_f32_32x32x16_bf16(PAF(0),VFR(4),o[1],0,0,0), C0,4); \
    KRD(GL,0); GAPB(o[0]=__builtin_amdgcn_mfma_f32_32x32x16_bf16(PAF(1),VFR(1),o[0],0,0,0), C0,8); \
    KRD(GL,1); GAPB(o[1]=__builtin_amdgcn_mfma_f32_32x32x16_bf16(PAF(1),VFR(5),o[1],0,0,0), C0,12); \
    KRD(GL,2); GAPB(o[0]=__builtin_amdgcn_mfma_f32_32x32x16_bf16(PAF(2),VFR(2),o[0],0,0,0), C1,0); \
    KRD(GL,3); GAPB(o[1]=__builtin_amdgcn_mfma_f32_32x32x16_bf16(PAF(2),VFR(6),o[1],0,0,0), C1,4); \
    GAPB(o[0]=__builtin_amdgcn_mfma_f32_32x32x16_bf16(PAF(3),VFR(3),o[0],0,0,0), C1,8); \
    GAPB(o[1]=__builtin_amdgcn_mfma_f32_32x32x16_bf16(PAF(3),VFR(7),o[1],0,0,0), C1,12); \
    }while(0)
  int t=1;
  #undef CMASK
  #define CMASK(P0,P1,t) do{}while(0)
  for(;t+5<NT;t+=2){
    STEP(pB0,pB1,pA0,pA1,t,true,true,true);     WAIT_BAR(2); RESC(); ROT();
    STEP(pA0,pA1,pB0,pB1,t+1,true,true,true);   WAIT_BAR(2); RESC(); ROT();
  }
  #undef CMASK
  #define CMASK(P0,P1,t) do{int jb_=(t)-(NT-4); if(jb_>=0)cmask(P0,P1,jb_,qrel,hi);}while(0)
  #define ENDW(tt) do{ if((tt)+3<NT){WAIT_BAR(2);} else if((tt)+2<NT){WAIT_BAR(1);} else {WAIT_BAR(0);} }while(0)
  for(;t+1<NT;t+=2){
    STEP(pB0,pB1,pA0,pA1,t,(t+3<NT),(t+1<NT),(t+1<NT));       ENDW(t);   RESC(); ROT();
    STEP(pA0,pA1,pB0,pB1,t+1,(t+4<NT),(t+2<NT),(t+2<NT));     ENDW(t+1); RESC(); ROT();
  }
  STEP(pB0,pB1,pA0,pA1,NT-1,false,false,false); RESC();
  { float sacc=pB0[0]+pB0[1]; _Pragma("unroll") for(int r=2;r<16;++r)sacc+=pB0[r]; _Pragma("unroll") for(int r=0;r<16;++r)sacc+=pB1[r]; l_reg+=sacc;
    pw0=(u32x4){PKW(pB0,0),PKW(pB0,2),PKW(pB0,4),PKW(pB0,6)};pw1=(u32x4){PKW(pB0,8),PKW(pB0,10),PKW(pB0,12),PKW(pB0,14)};pw2=(u32x4){PKW(pB1,0),PKW(pB1,2),PKW(pB1,4),PKW(pB1,6)};pw3=(u32x4){PKW(pB1,8),PKW(pB1,10),PKW(pB1,12),PKW(pB1,14)};
    SBAR(); pv(o,vb0+sl_cur,PAF(0),PAF(1),PAF(2),PAF(3)); }
  #undef PKW
  #undef PAF
  #undef VFR
  #undef PIN
  #undef MX3
  #undef GAPA
  #undef GAPB
  #undef EX
  #undef VRD
  #undef KRD
  #undef STEP
  #undef ENDW
  {auto rr=__builtin_amdgcn_permlane32_swap(__float_as_uint(l_reg),__float_as_uint(l_reg),false,false);l_reg=__uint_as_float(rr[0])+__uint_as_float(rr[1]);}
  if(hi==0)wsf[32+r32]=l_reg;asm volatile("s_waitcnt lgkmcnt(0)":::"memory");
  float rli[16];
  #pragma unroll
  for(int r=0;r<16;++r)rli[r]=__builtin_amdgcn_rcpf(wsf[32+crow(r,hi)]);
  bf16*Ow=O+(rowbase+q0+wid*QBLK)*DM+h*D;
  { bf16*stg=(bf16*)(shm+LDS_OST)+wid*2048;
    #pragma unroll
    for(int r=0;r<16;++r){const int orow=crow(r,hi);
      #pragma unroll
      for(int d0=0;d0<2;++d0)stg[orow*64+d0*32+r32]=__float2bfloat16(o[d0][r]*rli[r]);}
    asm volatile("s_waitcnt lgkmcnt(0)":::"memory");
    #pragma unroll
    for(int i=0;i<4;++i){const int row=i*8+(lane>>3),ch=lane&7; const u32x4 v=*(const u32x4*)(stg+row*64+ch*8); ATTN_STORE16(Ow+(long)row*DM+ch*8,v);} }
  asm volatile("s_waitcnt lgkmcnt(0)\n\ts_barrier":::"memory");
  #undef DMA_K
  #undef DMA_V
  #undef KAUG
  #undef QAUG
  #undef SETM
  #undef CMASK
  #undef START
  #undef RESC
  #undef ROT
}
constexpr int ATTN_LDS_BYTES=LDS_BYTES;
struct AttnTensors { const bf16* Q; const bf16* K; const bf16* V; bf16* O; const float* CUM; };
struct AttnUnit { int bh; int qb; };
struct StaticOrder {
  int vcu;
  __device__ __forceinline__ explicit StaticOrder(int grid,int block):vcu((block%8)*(grid/8)+block/8){}
  __device__ __forceinline__ bool next(int i,AttnUnit&u)const{ if(i>=2)return false; const int s=vcu&15; u.bh=vcu>>4; u.qb=(i==0)?s:31-s; return true; }
  __device__ __forceinline__ void a_ready(const AttnUnit&)const{}
  __device__ __forceinline__ void done(const AttnUnit&)const{}
};
template<class Sched,int THRL=8> __device__ __forceinline__ void attn_phase(char*lds,const AttnTensors&T,const Sched&S){
  AttnUnit u;
  for(int i=0;S.next(i,u);++i){ S.a_ready(u); attn_unit<THRL>(u.bh/NHEAD,u.bh%NHEAD,u.qb,T.Q,T.K,T.V,T.O,T.CUM,lds); S.done(u); }
}
#undef SBAR
#undef WAIT_BAR
}
namespace mk {
namespace cgx = cooperative_groups;

#ifdef PROBE_PHASE
#define TS(p) do { if (blockIdx.x == 0 && threadIdx.x == 0) { const unsigned long long now_ = __builtin_amdgcn_s_memrealtime(); tsl[p] += now_ - tsl[63]; tsl[63] = now_; } } while (0)
#define TSS(p) do { if (blockIdx.x == 0 && threadIdx.x == 0) { const unsigned long long now_ = __builtin_amdgcn_s_memrealtime(); tsl[16 + (p)] += now_ - tsl[63]; tsl[31] += now_ - tsl[63]; tsl[63] = now_; } } while (0)
#else
#define TS(p) do {} while (0)
#define TSS(p) do {} while (0)
#endif
#define GSYNCP(p) do { TS(p); GSYNC(); TSS(p); } while (0)
#define GSYNC() xcd_barrier(xbar)

#define PHASE_IDS() int tid_ = threadIdx.x; asm volatile("" : "+v"(tid_)); const int lane_ = tid_ & 63, wave_ = __builtin_amdgcn_readfirstlane(tid_ >> 6); \
    int bx_ = blockIdx.x; asm volatile("" : "+s"(bx_)); const int gw_ = bx_ * NWAVES + wave_, gt_ = bx_ * NTHR + tid_; unsigned char* ws_ = launder(a.ws); \
    (void)lane_; (void)gw_; (void)gt_; (void)ws_
__global__ void __launch_bounds__(NTHR, 2) mega_fwd(Args a) {
    extern __shared__ __attribute__((aligned(16))) unsigned char lds_raw[];
    cgx::grid_group grid = cgx::this_grid();
    LAS unsigned char* lds = (LAS unsigned char*)lds_raw;
    const int Gn = gridDim.x;
    const int NGW = Gn * NWAVES, NGT = Gn * NTHR;
    float* X = a.out;
    for (int u_ = threadIdx.x; u_ < (LDS_BYTES - RING_BYTES) / 4; u_ += NTHR) ((LAS unsigned*)(lds + RING_BYTES))[u_] = 0u;
    __syncthreads();
    const XcdBarrier xbar = xcd_barrier_post((unsigned*)(a.ws + WS_CTL) + 4096, (volatile LAS unsigned*)(lds + RING_BYTES + 1024));
#ifdef PROBE_PHASE
    volatile LAS unsigned long long* tsl = (volatile LAS unsigned long long*)(lds + RING_BYTES);
    if (blockIdx.x == 0 && threadIdx.x == 0) { for (int i = 0; i < 63; ++i) tsl[i] = 0ull; tsl[63] = __builtin_amdgcn_s_memrealtime(); }
#endif

    {
        PHASE_IDS(); LAS float* scr = (LAS float*)(lds + wave_ * 16384);
        for (int it = gw_; it < MODP_ITEMS + CV_TOTAL; it += NGW) { if (it < MODP_ITEMS) modp_item(a, it, lane_); else conv_item(a, 0, it - MODP_ITEMS, scr, lane_); }
        if (gt_ < 2 * 32 * 64) ssm_tables(a, gt_);
    }
    TS(0); __builtin_amdgcn_fence(__ATOMIC_RELEASE, "agent"); grid.sync(); __builtin_amdgcn_fence(__ATOMIC_ACQUIRE, "agent"); TSS(0);
    {
        PHASE_IDS();
        for (int i = gt_; i < 2 * 32 * 16 * 32 * 16; i += NGT) kt_entry(a, i);
        for (int i = gt_; i < 6 * 2 * 1024; i += NGT) coef_entry(a, i);
    }
    GSYNCP(1);
    {
        PHASE_IDS(); const float* COEF = (const float*)(ws_ + WS_COEF); bf16_t* XN = (bf16_t*)(ws_ + WS_XN);
        for (int m = gw_; m < M; m += NGW) prenorm_row(a.in[I_X] + (size_t)m * D, COEF + ((size_t)(0 * 2 + m / L) * 3 + 1) * D, XN + (size_t)m * D, lane_);
        for (int it = gw_; it < SSM_MAT_ITEMS; it += NGW) ssm_mat_item(a, 0, it, lane_);
    }
    GSYNCP(2);

    int sdone = 0;
    for (int l = 0; l < DEPTH; ++l) {
        if (l > 0) {
            PHASE_IDS(); LAS float* scr = (LAS float*)(lds + wave_ * 16384);
            for (int it = gw_; it < CV_TOTAL + SSM_MAT_ITEMS; it += NGW) { if (it < CV_TOTAL) conv_item(a, l, it, scr, lane_); else ssm_mat_item(a, l, it - CV_TOTAL, lane_); }
            GSYNCP(3);
        }
        for (int sub = 0; sub < 3; ++sub) {
            if (sdone >= a.n_sub) return;
            const int s = l * 3 + sub;
            const float* xin = (s == 0) ? a.in[I_X] : X;
            if (sub != 1) {
                const int f = sub == 0 ? 0 : 1;
                {
                    PHASE_IDS();
                    pg8::Gemm g{(const bf16_t*)(ws_ + WS_XN), (const bf16_t*)(ws_ + WS_WFI) + (size_t)f * 2 * FF * D, M, 2 * FF, D, D, D};
                    pg8::StaticOrder S; S.init(M, 2 * FF, Gn, bx_);
                    EpiSwiglu E{(bf16_t*)(ws_ + WS_AFFN), FF};
                    pg8::gemm_phase<EpiSwiglu, pg8::StaticOrder, true, true>(lds, g, S, E);
                }
                GSYNCP(4);
                {
                    PHASE_IDS();
                    pg8::Gemm g{(const bf16_t*)(ws_ + WS_AFFN), (const bf16_t*)(ws_ + WS_WFO) + (size_t)f * D * FF, M, D, FF, FF, FF};
                    pg8::StaticOrder S; S.init(M, D, Gn, bx_);
                    EpiF32 E{(float*)(ws_ + WS_Y), D};
                    pg8::gemm_phase<EpiF32, pg8::StaticOrder, true, true>(lds, g, S, E);
                }
                GSYNCP(5);
            } else {
                {
                    PHASE_IDS();
                    pg8::Gemm g{(const bf16_t*)(ws_ + WS_XN), (const bf16_t*)(ws_ + WS_WMI), M, INWP, D, D, D};
                    pg8::StaticOrder S; S.init(M, INWP, Gn, bx_);
                    EpiInProj E{(bf16_t*)(ws_ + WS_UG), (bf16_t*)(ws_ + WS_Q), (bf16_t*)(ws_ + WS_SGA), (float*)(ws_ + WS_LF), a.in[I_FB] + l * H};
                    pg8::gemm_phase<EpiInProj, pg8::StaticOrder, true, true>(lds, g, S, E);
                }
                GSYNCP(7);
                {
                    PHASE_IDS();
                    if (bx_ < 16) cum_block((const float*)(ws_ + WS_LF), (float*)(ws_ + WS_CUM), bx_, (LAS float*)lds, tid_);
                    pg8::Gemm g{(const bf16_t*)(ws_ + WS_UG), (const bf16_t*)(ws_ + WS_BTF), 32 * 512, 32 * 256, 512, UGK, 512};
                    LocalOrder S{bx_ - 16}; EpiLocal E{(float*)(ws_ + WS_LOCAL)};
                    pg8::gemm_phase<EpiLocal, LocalOrder, false, true>(lds, g, S, E);
                }
                GSYNCP(8);
                {
                    PHASE_IDS();
                    if (gt_ < 2 * 32 * 64) carry_scan(a, l, gt_);
                }
                GSYNCP(9);
                {
                    PHASE_IDS();
                    const attn_body::AttnTensors AT{(const attn_body::bf16*)(ws_ + WS_Q), (const attn_body::bf16*)(ws_ + WS_K), (const attn_body::bf16*)(ws_ + WS_V), (attn_body::bf16*)(ws_ + WS_Q), (const float*)(ws_ + WS_CUM)};
                    const attn_body::StaticOrder SA(Gn, bx_);
                    attn_body::attn_phase<attn_body::StaticOrder>((char*)lds_raw, AT, SA);
                }
                TS(10);
                {
                    PHASE_IDS();
                    pg8::Gemm g{(const bf16_t*)(ws_ + WS_UG), (const bf16_t*)(ws_ + WS_BTY), 32 * 512, 32 * 512, UGK, UGK, UGK};
                    SsmYOrder S{bx_}; EpiSsmY E{(const bf16_t*)(ws_ + WS_UG), (bf16_t*)(ws_ + WS_YS), a.in[I_SD] + l * 512};
                    pg8::gemm_phase<EpiSsmY, SsmYOrder, false, true>(lds, g, S, E);
                }
                GSYNCP(11);
                {
                    PHASE_IDS();
                    pg8::Gemm g{(const bf16_t*)(ws_ + WS_Q), (const bf16_t*)(ws_ + WS_WAO), M, D, 512, 512, 512};
                    pg8::StaticOrder S; S.init(M, D, Gn, bx_);
                    EpiAO E{(const bf16_t*)(ws_ + WS_SGB), (bf16_t*)(ws_ + WS_YBG)};
                    pg8::gemm_phase<EpiAO, pg8::StaticOrder, true, true>(lds, g, S, E);
                }
                GSYNCP(12);
                {
                    PHASE_IDS();
                    pg8::Gemm g{(const bf16_t*)(ws_ + WS_YS), (const bf16_t*)(ws_ + WS_WGLU), M, 2 * D, 512, 512, 512};
                    pg8::StaticOrder S; S.init(M, 2 * D, Gn, bx_);
                    EpiGLU E{(const bf16_t*)(ws_ + WS_SGA), (const bf16_t*)(ws_ + WS_YBG), (bf16_t*)(ws_ + WS_MERGED)};
                    pg8::gemm_phase<EpiGLU, pg8::StaticOrder, true, true>(lds, g, S, E);
                }
                GSYNCP(13);
                {
                    PHASE_IDS();
                    pg8::Gemm g{(const bf16_t*)(ws_ + WS_MERGED), (const bf16_t*)(ws_ + WS_WMO), M, D, D, D, D};
                    pg8::StaticOrder S; S.init(M, D, Gn, bx_);
                    EpiF32 E{(float*)(ws_ + WS_Y), D};
                    pg8::gemm_phase<EpiF32, pg8::StaticOrder, true, true>(lds, g, S, E);
                }
                GSYNCP(14);
            }
            {
                PHASE_IDS(); const float* COEF = (const float*)(ws_ + WS_COEF); bf16_t* XN = (bf16_t*)(ws_ + WS_XN); const float* Y = (const float*)(ws_ + WS_Y);
                const bool last = (s == 5);
                for (int m = gw_; m < M; m += NGW) { const int b = m / L;
                    postnorm_row(xin + (size_t)m * D, X + (size_t)m * D, Y + (size_t)m * D, COEF + ((size_t)(s * 2 + b) * 3 + 0) * D,
                                 last ? nullptr : COEF + ((size_t)((s + 1) * 2 + b) * 3 + 1) * D, last ? nullptr : XN + (size_t)m * D, lane_); }
            }
            GSYNCP(6);
            ++sdone;
        }
    }
#ifdef PROBE_XSYNC
    for (int i_ = 0; i_ < PROBE_XSYNC; ++i_) GSYNC();
#endif
#ifdef PROBE_PHASE
    if (blockIdx.x == 0 && threadIdx.x == 0) { const unsigned long long w_ = tsl[PROBE_PHASE] * (unsigned long long)PROBE_MULT, t0_ = __builtin_amdgcn_s_memrealtime(); while (__builtin_amdgcn_s_memrealtime() - t0_ < w_) __builtin_amdgcn_s_sleep(8); }
#endif
}

static int g_grid = 0;
static bool launch(const Args& a, hipStream_t stream) {
    if (g_grid == 0) {
        int dev = 0, cus = 0, per_cu = 0;
        if (hipGetDevice(&dev) != hipSuccess || hipDeviceGetAttribute(&cus, hipDeviceAttributeMultiprocessorCount, dev) != hipSuccess) { fprintf(stderr, "mk: device query failed\n"); g_grid = -1; return false; }
        if (hipFuncSetAttribute((const void*)mega_fwd, hipFuncAttributeMaxDynamicSharedMemorySize, LDS_BYTES) != hipSuccess) { fprintf(stderr, "mk: hipFuncSetAttribute failed\n"); g_grid = -1; return false; }
        if (hipOccupancyMaxActiveBlocksPerMultiprocessor(&per_cu, (const void*)mega_fwd, NTHR, LDS_BYTES) != hipSuccess || per_cu < 1) { fprintf(stderr, "mk: occupancy query says %d\n", per_cu); g_grid = -1; return false; }
        (void)hipGetLastError();
        g_grid = cus;
        fprintf(stderr, "mk: grid %d (per_cu %d)\n", g_grid, per_cu);
    }
    if (g_grid < 0) return false;
    Args al = a;
    void* params[] = {(void*)&al};
    const hipError_t e = hipLaunchCooperativeKernel((const void*)mega_fwd, dim3(g_grid), dim3(NTHR), params, LDS_BYTES, stream);
    if (e != hipSuccess) { fprintf(stderr, "mk: cooperative launch failed: %s\n", hipGetErrorString(e)); return false; }
    return true;
}
}
extern "C" void kernel_launch(void* const* d_in, const int* in_sizes, int n_in, void* d_out, int out_size, void* d_ws, size_t ws_size, hipStream_t stream) {
    if (n_in != 21 || ws_size < mk::WS_END || out_size != mk::M * mk::D) { fprintf(stderr, "kernel_launch: bad n_in %d, out %d or ws %zu\n", n_in, out_size, ws_size); return; }
    mk::Args a{};
    for (int i = 0; i < 21; ++i) a.in[i] = (const float*)d_in[i];
    a.out = (float*)d_out; a.ws = (unsigned char*)d_ws; a.n_sub = 6;
    if (hipMemsetAsync((char*)d_ws + mk::WS_CTL, 0, mk::MiB, stream) != hipSuccess) { fprintf(stderr, "kernel_launch: memset failed\n"); return; }
    (void)mk::launch(a, stream);
}
```
